# Optimizing an MI355X kernel written in HIP

```python
import jax, jax.numpy as jnp
from jax import lax
import numpy as np


D_MODEL = 1024
BATCH = 4
SEQ = 4096
DEPTH = 4

CHUNK = 64
Q_BLOCK = 128
NORM_EPS = 1e-6
D_FF = 256 * ((8 * D_MODEL // 3 + 255) // 256)

D_RNN = D_MODEL
RG_BLOCKS = 16
RG_BLOCK_W = D_RNN // RG_BLOCKS
CONV_W = 4
RG_C = 8.0

SB_HEAD_DIM = 128
SB_HEADS = D_MODEL // 128
SB_W = SB_HEADS * SB_HEAD_DIM

MLA_HEADS = 8
MLA_Q_LORA = D_MODEL // 4
MLA_KV_LORA = D_MODEL // 4
MLA_NOPE = 128
MLA_ROPE = 64
MLA_V = 128
MLA_V_W = MLA_HEADS * MLA_V
ROPE_THETA = 10000.0

N_BRANCHES = 3
IN_SPLITS = (D_RNN, D_RNN, SB_W, SB_W, SB_W, MLA_Q_LORA, MLA_KV_LORA, MLA_ROPE, N_BRANCHES * D_MODEL)
N_IN = D_RNN * 2 + SB_W * 3 + MLA_Q_LORA + MLA_KV_LORA + MLA_ROPE + N_BRANCHES * D_MODEL

kernel_name = 'hybrid_rglru_stickbreak_mla_macaron_trunk'


def rms_norm(x, g):
    xf = x.astype(jnp.float32)
    y = xf * lax.rsqrt(jnp.mean(xf * xf, axis=-1, keepdims=True) + NORM_EPS)
    return (y * g.astype(jnp.float32)).astype(x.dtype)


def swiglu_ffn(h, w_gate_up, w_down):
    gate, up = jnp.split(h @ w_gate_up, 2, axis=-1)
    return (jax.nn.silu(gate) * up) @ w_down


def causal_depthwise_conv(u, w, b):
    S = u.shape[1]
    up = jnp.pad(u, ((0, 0), (CONV_W - 1, 0), (0, 0)))
    out = b
    for tap in range(CONV_W):
        out = out + up[:, tap:tap + S] * w[tap]
    return out


def _lin_rec_combine(earlier, later):
    a1, b1 = earlier
    a2, b2 = later
    return a1 * a2, a2 * b1 + b2


def rg_lru(u, w_a, b_a, w_x, b_x, lam):
    B, S, _ = u.shape
    ub = u.reshape(B, S, RG_BLOCKS, RG_BLOCK_W)
    r = jax.nn.sigmoid(jnp.einsum('bsnj,njk->bsnk', ub, w_a).reshape(B, S, D_RNN) + b_a)
    i = jax.nn.sigmoid(jnp.einsum('bsnj,njk->bsnk', ub, w_x).reshape(B, S, D_RNN) + b_x)
    log_a = (-RG_C * jax.nn.softplus(-lam.astype(jnp.float32))) * r.astype(jnp.float32)
    a = jnp.exp(log_a)
    b = jnp.sqrt(-jnp.expm1(2.0 * log_a)) * (i * u).astype(jnp.float32)
    _, h = lax.associative_scan(_lin_rec_combine, (a, b), axis=1)
    return h.astype(u.dtype)


def stick_breaking_attention(q, k, v):
    S = q.shape[1]
    scale = SB_HEAD_DIM ** -0.5
    outs = []
    for blk in range(S // Q_BLOCK):
        q0 = blk * Q_BLOCK
        k_end = q0 + Q_BLOCK
        z = jnp.einsum('bqhd,bkhd->bhqk', q[:, q0:k_end], k[:, :k_end]).astype(jnp.float32) * scale
        q_pos = q0 + jnp.arange(Q_BLOCK)
        k_pos = jnp.arange(k_end)
        earlier = k_pos[None, :] < q_pos[:, None]
        log_keep = jnp.where(earlier, jax.nn.log_sigmoid(-z), 0.0)
        between = lax.cumsum(log_keep, axis=3, reverse=True) - log_keep
        w = jnp.where(earlier, jnp.exp(jax.nn.log_sigmoid(z) + between), 0.0)
        outs.append(jnp.einsum('bhqk,bkhd->bqhd', w.astype(v.dtype), v[:, :k_end]))
    return jnp.concatenate(outs, axis=1)


def chunk_causal_softmax_attention(q, k, v, scale):
    S = q.shape[1]
    outs = []
    for blk in range(S // Q_BLOCK):
        q0 = blk * Q_BLOCK
        k_end = q0 + Q_BLOCK
        s = jnp.einsum('bqhd,bkhd->bhqk', q[:, q0:k_end], k[:, :k_end]).astype(jnp.float32) * scale
        q_chunk = (q0 + jnp.arange(Q_BLOCK)) // CHUNK
        k_chunk = jnp.arange(k_end) // CHUNK
        s = jnp.where(k_chunk[None, :] <= q_chunk[:, None], s, -jnp.inf)
        p = jax.nn.softmax(s, axis=-1).astype(v.dtype)
        outs.append(jnp.einsum('bhqk,bkhd->bqhd', p, v[:, :k_end]))
    return jnp.concatenate(outs, axis=1)


def rope_tables(positions, dtype):
    inv = ROPE_THETA ** (-jnp.arange(0, MLA_ROPE, 2, dtype=jnp.float32) / MLA_ROPE)
    ang = positions.astype(jnp.float32)[..., None] * inv
    return jnp.cos(ang).astype(dtype), jnp.sin(ang).astype(dtype)


def apply_rope(x, cos, sin):
    x1, x2 = jnp.split(x, 2, axis=-1)
    return jnp.concatenate([x1 * cos - x2 * sin, x2 * cos + x1 * sin], axis=-1)


def mla_branch(c_q_raw, c_kv_raw, k_rope_raw, q_norm, w_uq, kv_norm, w_ukv, cos, sin):
    B, S, _ = c_q_raw.shape
    q = (rms_norm(c_q_raw, q_norm) @ w_uq).reshape(B, S, MLA_HEADS, MLA_NOPE + MLA_ROPE)
    q_nope, q_rope = jnp.split(q, [MLA_NOPE], axis=-1)
    q_rope = apply_rope(q_rope, cos[:, :, None, :], sin[:, :, None, :])
    kv = (rms_norm(c_kv_raw, kv_norm) @ w_ukv).reshape(B, S, MLA_HEADS, MLA_NOPE + MLA_V)
    k_nope, v = jnp.split(kv, [MLA_NOPE], axis=-1)
    k_rope = apply_rope(k_rope_raw, cos, sin)
    k = jnp.concatenate([k_nope, jnp.broadcast_to(k_rope[:, :, None, :], (B, S, MLA_HEADS, MLA_ROPE))], axis=-1)
    q = jnp.concatenate([q_nope, q_rope], axis=-1)
    o = chunk_causal_softmax_attention(q, k, v, (MLA_NOPE + MLA_ROPE) ** -0.5)
    return o.reshape(B, S, MLA_V_W)


def setup_inputs(seed: int = 0) -> dict:
    key = jax.random.key(seed)
    ks = iter(jax.random.split(key, 48))
    L, D = DEPTH, D_MODEL

    def normal(shape, fan_in):
        return jax.random.normal(next(ks), shape, jnp.float32) * (fan_in ** -0.5)

    def gain(shape):
        return 1.0 + 0.02 * jax.random.normal(next(ks), shape, jnp.float32)

    def bias(shape):
        return 0.02 * jax.random.normal(next(ks), shape, jnp.float32)

    x = jax.random.normal(next(ks), (BATCH, SEQ, D), jnp.float32)
    offsets = jax.random.randint(next(ks), (BATCH, 1), 0, 16384, dtype=jnp.int32)
    positions = (offsets + jnp.arange(SEQ, dtype=jnp.int32)[None, :]).astype(jnp.int32)
    a0 = jax.random.uniform(next(ks), (L, D_RNN), jnp.float32, minval=0.9, maxval=0.999)
    base = a0 ** (1.0 / RG_C)
    rg_lambda = jnp.log(base) - jnp.log1p(-base)
    return {
        'x': x,
        'positions': positions,
        'ffn1_norm': gain((L, D)),
        'ffn1_w_gate_up': normal((L, D, 2 * D_FF), D),
        'ffn1_w_down': normal((L, D_FF, D), D_FF),
        'mix_norm': gain((L, D)),
        'w_in': normal((L, D, N_IN), D),
        'conv_w': normal((L, CONV_W, D_RNN), CONV_W),
        'conv_b': bias((L, D_RNN)),
        'rg_w_a': normal((L, RG_BLOCKS, RG_BLOCK_W, RG_BLOCK_W), RG_BLOCK_W),
        'rg_b_a': bias((L, D_RNN)),
        'rg_w_x': normal((L, RG_BLOCKS, RG_BLOCK_W, RG_BLOCK_W), RG_BLOCK_W),
        'rg_b_x': bias((L, D_RNN)),
        'rg_lambda': rg_lambda,
        'mla_q_norm': gain((L, MLA_Q_LORA)),
        'mla_w_uq': normal((L, MLA_Q_LORA, MLA_HEADS * (MLA_NOPE + MLA_ROPE)), MLA_Q_LORA),
        'mla_kv_norm': gain((L, MLA_KV_LORA)),
        'mla_w_ukv': normal((L, MLA_KV_LORA, MLA_HEADS * (MLA_NOPE + MLA_V)), MLA_KV_LORA),
        'w_branch_a': normal((L, D_RNN, D), D_RNN),
        'w_branch_b': normal((L, SB_W, D), SB_W),
        'w_branch_c': normal((L, MLA_V_W, D), MLA_V_W),
        'w_out': normal((L, D, D), D),
        'ffn2_norm': gain((L, D)),
        'ffn2_w_gate_up': normal((L, D, 2 * D_FF), D),
        'ffn2_w_down': normal((L, D_FF, D), D_FF),
        'final_norm': gain((D,)),
    }


def reference(x, positions, ffn1_norm, ffn1_w_gate_up, ffn1_w_down, mix_norm, w_in,
              conv_w, conv_b, rg_w_a, rg_b_a, rg_w_x, rg_b_x, rg_lambda,
              mla_q_norm, mla_w_uq, mla_kv_norm, mla_w_ukv,
              w_branch_a, w_branch_b, w_branch_c, w_out,
              ffn2_norm, ffn2_w_gate_up, ffn2_w_down, final_norm):
    B, S, _ = x.shape
    split_points = []
    acc = 0
    for width in IN_SPLITS[:-1]:
        acc += width
        split_points.append(acc)
    cos, sin = rope_tables(positions, x.dtype)

    for l in range(DEPTH):
        x = x + 0.5 * swiglu_ffn(rms_norm(x, ffn1_norm[l]), ffn1_w_gate_up[l], ffn1_w_down[l])

        h = rms_norm(x, mix_norm[l])
        rg_x, rg_g, sb_q, sb_k, sb_v, c_q, c_kv, k_r, gate_logits = jnp.split(h @ w_in[l], split_points, axis=-1)

        u = causal_depthwise_conv(rg_x, conv_w[l], conv_b[l])
        y_a = rg_lru(u, rg_w_a[l], rg_b_a[l], rg_w_x[l], rg_b_x[l], rg_lambda[l]) * jax.nn.gelu(rg_g)

        hd = (B, S, SB_HEADS, SB_HEAD_DIM)
        y_b = stick_breaking_attention(sb_q.reshape(hd), sb_k.reshape(hd), sb_v.reshape(hd)).reshape(B, S, SB_W)

        y_c = mla_branch(c_q, c_kv, k_r, mla_q_norm[l], mla_w_uq[l], mla_kv_norm[l], mla_w_ukv[l], cos, sin)

        g_a, g_b, g_c = jnp.split(jax.nn.sigmoid(gate_logits), N_BRANCHES, axis=-1)
        merged = g_a * (y_a @ w_branch_a[l]) + g_b * (y_b @ w_branch_b[l]) + g_c * (y_c @ w_branch_c[l])
        x = x + merged @ w_out[l]

        x = x + 0.5 * swiglu_ffn(rms_norm(x, ffn2_norm[l]), ffn2_w_gate_up[l], ffn2_w_down[l])

    return rms_norm(x, final_norm)
```

```cpp
#include <hip/hip_runtime.h>
#include <hip/hip_cooperative_groups.h>
#include <stdint.h>
#include <stdio.h>
namespace cg = cooperative_groups;

#ifndef NAIVE_GEMM
#define NAIVE_GEMM 0
#endif
#ifndef NAIVE_ATTN
#define NAIVE_ATTN 0
#endif
#ifndef NAIVE_RG
#define NAIVE_RG 0
#endif
#ifndef PH_MASK
#define PH_MASK 0xFFFFF
#endif
#define EN(j) ((PH_MASK >> (j)) & 1)
#ifndef SINGLE_LAUNCH
#define SINGLE_LAUNCH 1
#endif

#define DI __device__ __forceinline__
typedef unsigned short bf16_t;
typedef __attribute__((ext_vector_type(8))) short bf16x8;
typedef __attribute__((ext_vector_type(16))) float f32x16;
typedef __attribute__((ext_vector_type(2))) __bf16 bf2v;
typedef __attribute__((ext_vector_type(2))) float f2v;
#define MFMA(a, b, c) __builtin_amdgcn_mfma_f32_32x32x16_bf16((a), (b), (c), 0, 0, 0)

constexpr int T_TOK = 16384, DM = 1024, SEQ = 4096, NBATCH = 4, DFF = 2816, NIN = 8768, DEPTH = 4;
constexpr int C_RGX = 0, C_RGG = 1024, C_SBQ = 2048, C_SBK = 3072, C_SBV = 4096, C_CQ = 5120, C_CKV = 5376, C_KR = 5632, C_GATE = 5696;
constexpr long W_GU1 = 0;
constexpr long W_D1 = W_GU1 + 5632L * 1024;
constexpr long W_IN = W_D1 + 1024L * 2816;
constexpr long W_UQ = W_IN + 8768L * 1024;
constexpr long W_UKV = W_UQ + 1536L * 256;
constexpr long W_BA = W_UKV + 2048L * 256;
constexpr long W_BB = W_BA + 1024L * 1024;
constexpr long W_BC = W_BB + 1024L * 1024;
constexpr long W_OUT = W_BC + 1024L * 1024;
constexpr long W_GU2 = W_OUT + 1024L * 1024;
constexpr long W_D2 = W_GU2 + 5632L * 1024;
constexpr long W_RGA = W_D2 + 1024L * 2816;
constexpr long W_RGX = W_RGA + 65536;
constexpr long W_TOTAL = W_RGX + 65536;

constexpr int NPH = 50;
constexpr int SMEM_GEMM = 2 * 2 * 128 * 72 * 2;
constexpr int SMEM_RINV = SMEM_GEMM;
constexpr int SMEM_ITEM = SMEM_GEMM + 512;
constexpr int SMEM_BYTES = SMEM_GEMM + 512 + 64;

struct Params {
  const void* in[26];
  float* xres;
  bf16_t* wb;
  bf16_t* hb;
  bf16_t* Y;
  bf16_t* qb;
  bf16_t* kb;
  bf16_t* vtc;
  bf16_t* vtb;
  float* cosb;
  float* sinb;
  int* counters;
  int ph_lo, ph_hi;
};

typedef const Params __attribute__((address_space(4)))* PP;
__device__ __forceinline__ PP get_params() { PP q = (PP)__builtin_amdgcn_kernarg_segment_ptr(); asm volatile("" : "+s"(q)); return q; }
__device__ __forceinline__ int otid() { int t = threadIdx.x; asm volatile("" : "+v"(t)); return t; }
DI unsigned pack2(float a, float b) { f2v v = {a, b}; bf2v r = __builtin_convertvector(v, bf2v); return __builtin_bit_cast(unsigned, r); }
DI bf16_t f2bf(float a) { return (bf16_t)(pack2(a, 0.f) & 0xffffu); }
DI float bf2f(bf16_t v) { return __uint_as_float(((unsigned)v) << 16); }
DI float bflo(unsigned u) { return __uint_as_float(u << 16); }
DI float bfhi(unsigned u) { return __uint_as_float(u & 0xffff0000u); }
DI int crow(int i, int h) { return (i & 3) + 8 * (i >> 2) + 4 * h; }
DI float sigmoidf_(float x) { return 1.f / (1.f + __expf(-x)); }
DI float gelu_tanh(float x) { float u = 0.7978845608028654f * (x + 0.044715f * x * x * x); return 0.5f * x * (1.f + tanhf(u)); }
DI void store4bf(bf16_t* p, const float (&v)[4]) { uint2 u; u.x = pack2(v[0], v[1]); u.y = pack2(v[2], v[3]); *(uint2*)p = u; }

struct GemmSpec {
  const bf16_t* A; int lda;
  const bf16_t* Bt; int K;
  int Nv;
  const float* W; int ldw;
  int mapmode;
  const float* kscale;
};
DI int wcol(int mode, int n) {
  if (mode == 0) return n;
  int blk = n >> 6, which = (n >> 5) & 1, j = blk * 32 + (n & 31);
  return which * DFF + j;
}

constexpr int LROW = 72;

template <int NI>
DI void gemm_main(const GemmSpec& g, int m0, int n0, f32x16 (&acc)[2][NI], char* smem) {
  const int tid = otid(), lane = tid & 63, wave = tid >> 6;
  const int r = lane & 31, hh = lane >> 5, wm = wave >> 1, wn = wave & 1;
#pragma unroll
  for (int a = 0; a < 2; ++a)
#pragma unroll
    for (int b = 0; b < NI; ++b)
#pragma unroll
      for (int i = 0; i < 16; ++i) acc[a][b][i] = 0.f;
  __syncthreads();
#if !NAIVE_GEMM
  bf16_t* sA = (bf16_t*)smem;
  bf16_t* sB = sA + 2 * 128 * LROW;
  const int srow = tid >> 3, skc = tid & 7;
  const bf16_t* Ap = g.A + (long)(m0 + srow) * g.lda + skc * 8;
  const bf16_t* Bp[2 * NI];
#pragma unroll
  for (int i = 0; i < 2 * NI; ++i) { int br = n0 + srow + 32 * i; br = br < g.Nv ? br : g.Nv - 1; Bp[i] = g.Bt + (long)br * g.K + skc * 8; }
  uint4 ra[4], rb[2 * NI];
  const int KT = g.K >> 6;
#pragma unroll
  for (int i = 0; i < 4; ++i) { ra[i] = *(const uint4*)(Ap + (long)(32 * i) * g.lda); if (i < 2 * NI) rb[i] = *(const uint4*)(Bp[i]); }
#pragma unroll
  for (int i = 0; i < 4; ++i) { *(uint4*)(sA + (srow + 32 * i) * LROW + skc * 8) = ra[i]; if (i < 2 * NI) *(uint4*)(sB + (srow + 32 * i) * LROW + skc * 8) = rb[i]; }
  __syncthreads();
  for (int kt = 0; kt < KT; ++kt) {
    const int buf = kt & 1;
    if (kt + 1 < KT) {
#pragma unroll
      for (int i = 0; i < 4; ++i) { ra[i] = *(const uint4*)(Ap + (long)(32 * i) * g.lda + (kt + 1) * 64); if (i < 2 * NI) rb[i] = *(const uint4*)(Bp[i] + (kt + 1) * 64); }
    }
    const bf16_t* cA = sA + buf * 128 * LROW + (wm * 64 + r) * LROW + hh * 8;
    const bf16_t* cB = sB + buf * (64 * NI) * LROW + (wn * 32 * NI + r) * LROW + hh * 8;
#pragma unroll
    for (int kk = 0; kk < 4; ++kk) {
      bf16x8 bfr[NI], afr[2];
#pragma unroll
      for (int ni = 0; ni < NI; ++ni) bfr[ni] = *(const bf16x8*)(cB + ni * 32 * LROW + kk * 16);
#pragma unroll
      for (int mi = 0; mi < 2; ++mi) afr[mi] = *(const bf16x8*)(cA + mi * 32 * LROW + kk * 16);
#pragma unroll
      for (int mi = 0; mi < 2; ++mi)
#pragma unroll
        for (int ni = 0; ni < NI; ++ni) acc[mi][ni] = MFMA(bfr[ni], afr[mi], acc[mi][ni]);
    }
    if (kt + 1 < KT) {
      const int nb = buf ^ 1;
#pragma unroll
      for (int i = 0; i < 4; ++i) { *(uint4*)(sA + nb * 128 * LROW + (srow + 32 * i) * LROW + skc * 8) = ra[i]; if (i < 2 * NI) *(uint4*)(sB + nb * (64 * NI) * LROW + (srow + 32 * i) * LROW + skc * 8) = rb[i]; }
    }
    __syncthreads();
  }
#else
  float* As = (float*)smem;
  float* Ws = As + 128 * 17;
  for (int k0 = 0; k0 < g.K; k0 += 16) {
    {
      int row = tid >> 1, half = tid & 1;
      uint4 v = *(const uint4*)(g.A + (long)(m0 + row) * g.lda + k0 + half * 8);
      float* d = As + row * 17 + half * 8;
      d[0] = bflo(v.x); d[1] = bfhi(v.x); d[2] = bflo(v.y); d[3] = bfhi(v.y); d[4] = bflo(v.z); d[5] = bfhi(v.z); d[6] = bflo(v.w); d[7] = bfhi(v.w);
      int kk = tid >> 4, c8 = (tid & 15) * 4 * NI;
      float ks = g.kscale ? g.kscale[k0 + kk] : 1.f;
#pragma unroll
      for (int q = 0; q < NI; ++q) {
        int n = n0 + c8 + q * 4;
        float4 w = make_float4(0.f, 0.f, 0.f, 0.f);
        if (n < g.Nv) w = *(const float4*)(g.W + (long)(k0 + kk) * g.ldw + wcol(g.mapmode, n));
        float* dw = Ws + kk * (64 * NI) + c8 + q * 4;
        dw[0] = w.x * ks; dw[1] = w.y * ks; dw[2] = w.z * ks; dw[3] = w.w * ks;
      }
    }
    __syncthreads();
#pragma unroll 1
    for (int k = 0; k < 16; ++k) {
#pragma unroll
      for (int mi = 0; mi < 2; ++mi) {
        float a = As[(wm * 64 + mi * 32 + r) * 17 + k];
#pragma unroll
        for (int ni = 0; ni < NI; ++ni)
#pragma unroll
          for (int gq = 0; gq < 4; ++gq) {
            float4 w = *(const float4*)(Ws + k * (64 * NI) + wn * 32 * NI + ni * 32 + 8 * gq + 4 * hh);
            acc[mi][ni][4 * gq + 0] += a * w.x; acc[mi][ni][4 * gq + 1] += a * w.y; acc[mi][ni][4 * gq + 2] += a * w.z; acc[mi][ni][4 * gq + 3] += a * w.w;
          }
      }
    }
    __syncthreads();
  }
#endif
}

template <class Epi>
DI void gemm_epi(f32x16 (&acc)[2][2], int m0, int n0, int Nv, Epi& epi) {
  const int lane = otid() & 63, wave = otid() >> 6;
  const int r = lane & 31, hh = lane >> 5, wm = wave >> 1, wn = wave & 1;
  if (n0 + wn * 64 >= Nv) return;
#pragma unroll
  for (int mi = 0; mi < 2; ++mi)
#pragma unroll
    for (int gq = 0; gq < 4; ++gq) {
      float v0[4], v1[4];
#pragma unroll
      for (int j = 0; j < 4; ++j) { v0[j] = acc[mi][0][4 * gq + j]; v1[j] = acc[mi][1][4 * gq + j]; }
      epi(m0 + wm * 64 + mi * 32 + r, n0 + wn * 64 + 8 * gq + 4 * hh, v0, v1);
    }
}

struct EpiSwiglu {
  bf16_t* act;
  DI void operator()(int m, int n, const float (&v0)[4], const float (&v1)[4]) {
    float o[4];
#pragma unroll
    for (int j = 0; j < 4; ++j) o[j] = v0[j] * sigmoidf_(v0[j]) * v1[j];
    store4bf(act + (long)m * DFF + (n >> 6) * 32 + (n & 63), o);
  }
};
struct EpiResid {
  float* x; float scale;
  DI void operator()(int m, int n, const float (&v0)[4], const float (&v1)[4]) {
    float4* p0 = (float4*)(x + (long)m * DM + n);
    float4* p1 = (float4*)(x + (long)m * DM + n + 32);
    float4 a = *p0, b = *p1;
    a.x += scale * v0[0]; a.y += scale * v0[1]; a.z += scale * v0[2]; a.w += scale * v0[3];
    b.x += scale * v1[0]; b.y += scale * v1[1]; b.z += scale * v1[2]; b.w += scale * v1[3];
    *p0 = a; *p1 = b;
  }
};
struct EpiWin {
  bf16_t* Y; bf16_t* vtb; const float* cosb; const float* sinb;
  DI void operator()(int m, int n, const float (&v0)[4], const float (&v1)[4]) {
    const int nb = n & ~63;
    if (nb >= C_SBV && nb < C_CQ) {
      int c = n - C_SBV, head = c >> 7, d = c & 127, b = m >> 12, s = m & 4095;
      bf16_t* base = vtb + ((long)((b * 8 + head) * 128 + d)) * SEQ + s;
#pragma unroll
      for (int j = 0; j < 4; ++j) { base[(long)j * SEQ] = f2bf(v0[j]); base[(long)(j + 32) * SEQ] = f2bf(v1[j]); }
    } else if (nb == C_KR) {
      int i0 = n - C_KR;
      float4 c = *(const float4*)(cosb + (long)m * 32 + i0), s = *(const float4*)(sinb + (long)m * 32 + i0);
      float cc[4] = {c.x, c.y, c.z, c.w}, ss[4] = {s.x, s.y, s.z, s.w}, o1[4], o2[4];
#pragma unroll
      for (int j = 0; j < 4; ++j) { o1[j] = v0[j] * cc[j] - v1[j] * ss[j]; o2[j] = v1[j] * cc[j] + v0[j] * ss[j]; }
      store4bf(Y + (long)m * NIN + n, o1); store4bf(Y + (long)m * NIN + n + 32, o2);
    } else {
      store4bf(Y + (long)m * NIN + n, v0); store4bf(Y + (long)m * NIN + n + 32, v1);
    }
  }
};
struct EpiQ {
  bf16_t* qb; const float* rinv; int m0; const float* cosb; const float* sinb;
  DI void operator()(int m, int n, const float (&v0)[4], const float (&v1)[4]) {
    const float ri = rinv[m - m0];
    const int nb = n & ~63;
    float a[4], b[4];
#pragma unroll
    for (int j = 0; j < 4; ++j) { a[j] = v0[j] * ri; b[j] = v1[j] * ri; }
    if ((nb % 192) == 128) {
      int i0 = n - nb;
      float4 c = *(const float4*)(cosb + (long)m * 32 + i0), s = *(const float4*)(sinb + (long)m * 32 + i0);
      float cc[4] = {c.x, c.y, c.z, c.w}, ss[4] = {s.x, s.y, s.z, s.w}, o1[4], o2[4];
#pragma unroll
      for (int j = 0; j < 4; ++j) { o1[j] = a[j] * cc[j] - b[j] * ss[j]; o2[j] = b[j] * cc[j] + a[j] * ss[j]; }
      store4bf(qb + (long)m * 1536 + n, o1); store4bf(qb + (long)m * 1536 + n + 32, o2);
    } else {
      store4bf(qb + (long)m * 1536 + n, a); store4bf(qb + (long)m * 1536 + n + 32, b);
    }
  }
};
struct EpiKV {
  bf16_t* kb; bf16_t* vtc; const float* rinv; int m0;
  DI void operator()(int m, int n, const float (&v0)[4], const float (&v1)[4]) {
    const float ri = rinv[m - m0];
    const int head = n >> 8, w = n & 255;
    if (w < 128) {
      float a[4], b[4];
#pragma unroll
      for (int j = 0; j < 4; ++j) { a[j] = v0[j] * ri; b[j] = v1[j] * ri; }
      store4bf(kb + (long)m * 1024 + head * 128 + w, a); store4bf(kb + (long)m * 1024 + head * 128 + w + 32, b);
    } else {
      int d = w - 128, bb = m >> 12, s = m & 4095;
      bf16_t* base = vtc + ((long)((bb * 8 + head) * 128 + d)) * SEQ + s;
#pragma unroll
      for (int j = 0; j < 4; ++j) { base[(long)j * SEQ] = f2bf(v0[j] * ri); base[(long)(j + 32) * SEQ] = f2bf(v1[j] * ri); }
    }
  }
};

DI void conv_tile(const float* src, int ldsrc, int k0, int n0, bf16_t* dst, int ldd, int mode, const float* kscale, char* smem) {
  float* tile = (float*)smem;
  const int tid = otid();
  __syncthreads();
#pragma unroll
  for (int i = 0; i < 4; ++i) {
    int kk = (tid >> 4) + 16 * i, nn = (tid & 15) * 4;
    float4 v = *(const float4*)(src + (long)(k0 + kk) * ldsrc + n0 + nn);
    float s = kscale ? kscale[k0 + kk] : 1.f;
    tile[(nn + 0) * 65 + kk] = v.x * s; tile[(nn + 1) * 65 + kk] = v.y * s; tile[(nn + 2) * 65 + kk] = v.z * s; tile[(nn + 3) * 65 + kk] = v.w * s;
  }
  __syncthreads();
  {
    int nn = tid >> 2, ks = (tid & 3) * 16;
    const float* t = tile + nn * 65 + ks;
    uint4 a, b;
    a.x = pack2(t[0], t[1]); a.y = pack2(t[2], t[3]); a.z = pack2(t[4], t[5]); a.w = pack2(t[6], t[7]);
    b.x = pack2(t[8], t[9]); b.y = pack2(t[10], t[11]); b.z = pack2(t[12], t[13]); b.w = pack2(t[14], t[15]);
    int n = n0 + nn, drow;
    if (mode == 0) drow = n;
    else { int which = n >= DFF ? 1 : 0, j = n - which * DFF; drow = (j >> 5) * 64 + which * 32 + (j & 31); }
    bf16_t* d = dst + (long)drow * ldd + k0 + ks;
    *(uint4*)d = a; *(uint4*)(d + 8) = b;
  }
}

DI void convert_layer(int l, char* smem) {
  PP p = get_params();
  const int nGU = 1408, nD = 704, nIN = 2192, nUQ = 96, nUKV = 128, nSQ = 256, nRG = 16;
  const int total = 2 * nGU + 2 * nD + nIN + nUQ + nUKV + 4 * nSQ + 2 * nRG;
  bf16_t* wb = p->wb;
  for (int t = blockIdx.x; t < total; t += gridDim.x) {
    int u = t;
    const float* src; int K, N; bf16_t* dst; int mode = 0; const float* ks = nullptr;
    if (u < nGU) { src = (const float*)p->in[3] + (long)l * 1024 * 5632; K = 1024; N = 5632; dst = wb + W_GU1; mode = 1; }
    else if ((u -= nGU) < nD) { src = (const float*)p->in[4] + (long)l * 2816 * 1024; K = 2816; N = 1024; dst = wb + W_D1; }
    else if ((u -= nD) < nIN) { src = (const float*)p->in[6] + (long)l * 1024 * 8768; K = 1024; N = 8768; dst = wb + W_IN; }
    else if ((u -= nIN) < nUQ) { src = (const float*)p->in[15] + (long)l * 256 * 1536; K = 256; N = 1536; dst = wb + W_UQ; ks = (const float*)p->in[14] + l * 256; }
    else if ((u -= nUQ) < nUKV) { src = (const float*)p->in[17] + (long)l * 256 * 2048; K = 256; N = 2048; dst = wb + W_UKV; ks = (const float*)p->in[16] + l * 256; }
    else if ((u -= nUKV) < nSQ) { src = (const float*)p->in[18] + (long)l * 1024 * 1024; K = 1024; N = 1024; dst = wb + W_BA; }
    else if ((u -= nSQ) < nSQ) { src = (const float*)p->in[19] + (long)l * 1024 * 1024; K = 1024; N = 1024; dst = wb + W_BB; }
    else if ((u -= nSQ) < nSQ) { src = (const float*)p->in[20] + (long)l * 1024 * 1024; K = 1024; N = 1024; dst = wb + W_BC; }
    else if ((u -= nSQ) < nSQ) { src = (const float*)p->in[21] + (long)l * 1024 * 1024; K = 1024; N = 1024; dst = wb + W_OUT; }
    else if ((u -= nSQ) < nGU) { src = (const float*)p->in[23] + (long)l * 1024 * 5632; K = 1024; N = 5632; dst = wb + W_GU2; mode = 1; }
    else if ((u -= nGU) < nD) { src = (const float*)p->in[24] + (long)l * 2816 * 1024; K = 2816; N = 1024; dst = wb + W_D2; }
    else if ((u -= nD) < nRG) { src = (const float*)p->in[9] + (long)l * 65536 + (long)u * 4096; K = 64; N = 64; dst = wb + W_RGA + (long)u * 4096; u = 0; }
    else { u -= nRG; src = (const float*)p->in[11] + (long)l * 65536 + (long)u * 4096; K = 64; N = 64; dst = wb + W_RGX + (long)u * 4096; u = 0; }
    int ntn = N >> 6;
    int kt = u / ntn, nt = u - kt * ntn;
    conv_tile(src, N, kt * 64, nt * 64, dst, K, mode, ks, smem);
  }
}

template <bool FINAL>
DI void norm_phase(const float* x, const float* g, bf16_t* outb, float* outf) {
  const int lane = otid() & 63;
  const int gw = blockIdx.x * 4 + (otid() >> 6), nw = gridDim.x * 4;
  float4 gg[4];
#pragma unroll
  for (int i = 0; i < 4; ++i) gg[i] = *(const float4*)(g + lane * 4 + 256 * i);
  for (int row = gw; row < T_TOK; row += nw) {
    const float* xr = x + (long)row * DM;
    float4 v[4]; float ss = 0.f;
#pragma unroll
    for (int i = 0; i < 4; ++i) { v[i] = *(const float4*)(xr + lane * 4 + 256 * i); ss += v[i].x * v[i].x + v[i].y * v[i].y + v[i].z * v[i].z + v[i].w * v[i].w; }
#pragma unroll
    for (int o = 32; o >= 1; o >>= 1) ss += __shfl_xor(ss, o);
    const float ri = rsqrtf(ss * (1.f / 1024.f) + 1e-6f);
#pragma unroll
    for (int i = 0; i < 4; ++i) {
      float o[4] = {v[i].x * ri * gg[i].x, v[i].y * ri * gg[i].y, v[i].z * ri * gg[i].z, v[i].w * ri * gg[i].w};
      if (FINAL) *(float4*)(outf + (long)row * DM + lane * 4 + 256 * i) = make_float4(o[0], o[1], o[2], o[3]);
      else store4bf(outb + (long)row * DM + lane * 4 + 256 * i, o);
    }
  }
}

template <class Epi>
DI void gemm_phase(const GemmSpec& g, Epi& epi, char* smem) {
  const int ntn = (g.Nv + 127) >> 7, ntm = T_TOK >> 7;
  for (int t = blockIdx.x; t < ntn * ntm; t += gridDim.x) {
    int mt = t / ntn, nt = t - mt * ntn;
    f32x16 acc[2][2];
    gemm_main<2>(g, mt * 128, nt * 128, acc, smem);
    gemm_epi(acc, mt * 128, nt * 128, g.Nv, epi);
  }
}

DI void merge_phase(int l, char* smem) {
  PP p = get_params();
  for (int t = blockIdx.x; t < 16 * 128; t += gridDim.x) {
    const int mt = t >> 4, nt = t & 15, m0 = mt * 128, n0 = nt * 64;
    const int lane = otid() & 63, wave = otid() >> 6;
    const int r = lane & 31, hh = lane >> 5, wm = wave >> 1, wn = wave & 1;
    f32x16 tot[2];
#pragma unroll
    for (int a = 0; a < 2; ++a)
#pragma unroll
      for (int i = 0; i < 16; ++i) tot[a][i] = 0.f;
#pragma unroll 1
    for (int br = 0; br < 3; ++br) {
      GemmSpec g;
      if (br == 0) { g.A = p->Y + C_RGG; g.lda = NIN; g.Bt = p->wb + W_BA; g.W = (const float*)p->in[18] + (long)l * 1048576; }
      else if (br == 1) { g.A = p->Y + C_SBQ; g.lda = NIN; g.Bt = p->wb + W_BB; g.W = (const float*)p->in[19] + (long)l * 1048576; }
      else { g.A = p->hb; g.lda = 1024; g.Bt = p->wb + W_BC; g.W = (const float*)p->in[20] + (long)l * 1048576; }
      g.K = 1024; g.Nv = 1024; g.ldw = 1024; g.mapmode = 0; g.kscale = nullptr;
      f32x16 acc[2][1];
      gemm_main<1>(g, m0, n0, acc, smem);
      const bf16_t* gbase = p->Y + C_GATE + br * 1024;
#pragma unroll
      for (int mi = 0; mi < 2; ++mi)
#pragma unroll
        for (int gq = 0; gq < 4; ++gq) {
          int m = m0 + wm * 64 + mi * 32 + r, n = n0 + wn * 32 + 8 * gq + 4 * hh;
          uint2 gl = *(const uint2*)(gbase + (long)m * NIN + n);
          tot[mi][4 * gq + 0] += sigmoidf_(bflo(gl.x)) * acc[mi][0][4 * gq + 0];
          tot[mi][4 * gq + 1] += sigmoidf_(bfhi(gl.x)) * acc[mi][0][4 * gq + 1];
          tot[mi][4 * gq + 2] += sigmoidf_(bflo(gl.y)) * acc[mi][0][4 * gq + 2];
          tot[mi][4 * gq + 3] += sigmoidf_(bfhi(gl.y)) * acc[mi][0][4 * gq + 3];
        }
    }
#pragma unroll
    for (int mi = 0; mi < 2; ++mi)
#pragma unroll
      for (int gq = 0; gq < 4; ++gq) {
        int m = m0 + wm * 64 + mi * 32 + r, n = n0 + wn * 32 + 8 * gq + 4 * hh;
        float o[4] = {tot[mi][4 * gq], tot[mi][4 * gq + 1], tot[mi][4 * gq + 2], tot[mi][4 * gq + 3]};
        store4bf(p->qb + (long)m * 1024 + n, o);
      }
  }
}

DI void rg_item(int l, int item, char* smem) {
  PP p = get_params();
  const int b = item >> 4, nb = item & 15, cb = nb * 64;
  const int tid = otid(), lane = tid & 63, wave = tid >> 6, r = lane & 31, hh = lane >> 5;
  float* xs = (float*)smem;
  float* aa = xs;
  float* uf = xs + 67 * 64;
  bf16_t* ub = (bf16_t*)(uf + 64 * 64);
  bf16_t* wa = ub + 64 * 72;
  bf16_t* wx = wa + 64 * 72;
  float* cst = (float*)(wx + 64 * 72);
  __syncthreads();
  if (tid < 64) {
    int ch = cb + tid;
    cst[0 * 64 + tid] = ((const float*)p->in[10])[l * 1024 + ch];
    cst[1 * 64 + tid] = ((const float*)p->in[12])[l * 1024 + ch];
    float lam = ((const float*)p->in[13])[l * 1024 + ch];
    cst[2 * 64 + tid] = log1pf(expf(-lam));
    cst[3 * 64 + tid] = ((const float*)p->in[8])[l * 1024 + ch];
#pragma unroll
    for (int tap = 0; tap < 4; ++tap) cst[(4 + tap) * 64 + tid] = ((const float*)p->in[7])[(l * 4 + tap) * 1024 + ch];
  }
  for (int e = tid; e < 64 * 8; e += 256) {
    int row = e >> 3, kc = e & 7;
    *(uint4*)(wa + row * 72 + kc * 8) = *(const uint4*)(p->wb + W_RGA + nb * 4096 + row * 64 + kc * 8);
    *(uint4*)(wx + row * 72 + kc * 8) = *(const uint4*)(p->wb + W_RGX + nb * 4096 + row * 64 + kc * 8);
  }
  float hstate = 0.f;
  bf16_t* Yb = p->Y + (long)b * SEQ * NIN;
  for (int c = 0; c < 64; ++c) {
    const int t0 = c * 64;
    __syncthreads();
    for (int e = tid; e < 67 * 64; e += 256) {
      int rr = e >> 6, ch = e & 63, t = t0 - 3 + rr;
      xs[e] = t >= 0 ? bf2f(Yb[(long)t * NIN + C_RGX + cb + ch]) : 0.f;
    }
    __syncthreads();
    {
      const int ch = tid & 63, tq = tid >> 6;
      const float cbias = cst[3 * 64 + ch], w0 = cst[4 * 64 + ch], w1 = cst[5 * 64 + ch], w2 = cst[6 * 64 + ch], w3 = cst[7 * 64 + ch];
#pragma unroll 4
      for (int tt = 0; tt < 16; ++tt) {
        int t = tq * 16 + tt;
        float u = cbias + w0 * xs[(t + 0) * 64 + ch] + w1 * xs[(t + 1) * 64 + ch] + w2 * xs[(t + 2) * 64 + ch] + w3 * xs[(t + 3) * 64 + ch];
        uf[t * 64 + ch] = u;
        ub[t * 72 + ch] = f2bf(u);
      }
    }
    __syncthreads();
    {
      const int tb = 32 * (wave >> 1), cb2 = 32 * (wave & 1);
      f32x16 accA, accX;
#pragma unroll
      for (int i = 0; i < 16; ++i) { accA[i] = 0.f; accX[i] = 0.f; }
#if !NAIVE_RG
#pragma unroll
      for (int kk = 0; kk < 4; ++kk) {
        bf16x8 uu = *(const bf16x8*)(ub + (tb + r) * 72 + kk * 16 + hh * 8);
        bf16x8 fa = *(const bf16x8*)(wa + (cb2 + r) * 72 + kk * 16 + hh * 8);
        bf16x8 fx = *(const bf16x8*)(wx + (cb2 + r) * 72 + kk * 16 + hh * 8);
        accA = MFMA(fa, uu, accA);
        accX = MFMA(fx, uu, accX);
      }
#else
      {
        const float* Wa = (const float*)p->in[9] + (long)l * 65536 + nb * 4096;
        const float* Wx = (const float*)p->in[11] + (long)l * 65536 + nb * 4096;
        for (int j = 0; j < 64; ++j) {
          float u = uf[(tb + r) * 64 + j];
#pragma unroll
          for (int i = 0; i < 16; ++i) { int ko = cb2 + crow(i, hh); accA[i] += u * Wa[j * 64 + ko]; accX[i] += u * Wx[j * 64 + ko]; }
        }
      }
#endif
#pragma unroll
      for (int i = 0; i < 16; ++i) {
        int ch = cb2 + crow(i, hh), t = tb + r;
        float rg = sigmoidf_(accA[i] + cst[0 * 64 + ch]);
        float ig = sigmoidf_(accX[i] + cst[1 * 64 + ch]);
        float la = -8.f * cst[2 * 64 + ch] * rg;
        float a = __expf(la);
        float bc = sqrtf(-expm1f(2.f * la)) * ig * uf[t * 64 + ch];
        aa[t * 64 + ch] = a;
        uf[t * 64 + ch] = bc;
      }
    }
    __syncthreads();
    if (wave == 0) {
      bf16_t* gp = Yb + (long)t0 * NIN + C_RGG + cb + lane;
#pragma unroll 8
      for (int t = 0; t < 64; ++t) {
        hstate = aa[t * 64 + lane] * hstate + uf[t * 64 + lane];
        float gv = bf2f(gp[(long)t * NIN]);
        gp[(long)t * NIN] = f2bf(hstate * gelu_tanh(gv));
      }
    }
  }
}

constexpr float SB_SCALE = 0.08838834764831845f;
constexpr float MLA_SCALE = 0.07216878364870323f;

DI void sb_item(int item, char* smem) {
  PP p = get_params();
  const int qblk = 31 - (item >> 5), bh = item & 31, b = bh >> 3, hd = bh & 7;
  const int tid = otid(), lane = tid & 63, wave = tid >> 6, r = lane & 31, hh = lane >> 5;
  bf16_t* Yb = p->Y + (long)b * SEQ * NIN;
  const int qs = qblk * 128 + wave * 32;
#if !NAIVE_ATTN
  bf16_t* sK = (bf16_t*)smem;
  bf16_t* sV = sK + 64 * 136;
  bf16x8 qf[8];
#pragma unroll
  for (int kk = 0; kk < 8; ++kk) qf[kk] = *(const bf16x8*)(Yb + (long)(qs + r) * NIN + C_SBQ + hd * 128 + kk * 16 + hh * 8);
  f32x16 o[4];
#pragma unroll
  for (int dt = 0; dt < 4; ++dt)
#pragma unroll
    for (int i = 0; i < 16; ++i) o[dt][i] = 0.f;
  float cy = 0.f;
  const bf16_t* Kg = Yb + C_SBK + hd * 128;
  const bf16_t* Vg = p->vtb + (long)(b * 8 + hd) * 128 * SEQ;
  const int ntiles = qblk * 2 + 2;
  const int krow_ = tid >> 4, kkc = tid & 15, vrow = tid >> 3, vkc = tid & 7;
  uint4 rk0, rk1, rk2, rk3, rv0, rv1, rv2, rv3;
  const bf16_t* kgp = Kg + (long)krow_ * NIN + kkc * 8;
  const bf16_t* vgp = Vg + (long)vrow * SEQ + vkc * 8;
#define SB_LOAD(KT) { const bf16_t* kq = kgp + (long)((KT) * 64) * NIN; const bf16_t* vq = vgp + (KT) * 64; \
    rk0 = *(const uint4*)(kq); rk1 = *(const uint4*)(kq + 16L * NIN); rk2 = *(const uint4*)(kq + 32L * NIN); rk3 = *(const uint4*)(kq + 48L * NIN); \
    rv0 = *(const uint4*)(vq); rv1 = *(const uint4*)(vq + 32L * SEQ); rv2 = *(const uint4*)(vq + 64L * SEQ); rv3 = *(const uint4*)(vq + 96L * SEQ); }
#define ST_V(ROW, RV) { uint2* dv = (uint2*)(sV + (ROW) * 68 + vkc * 8); dv[0] = make_uint2(RV.x, RV.y); dv[1] = make_uint2(RV.z, RV.w); }
  SB_LOAD(ntiles - 1)
  for (int kt = ntiles - 1; kt >= 0; --kt) {
    __syncthreads();
    *(uint4*)(sK + (krow_) * 136 + kkc * 8) = rk0; *(uint4*)(sK + (krow_ + 16) * 136 + kkc * 8) = rk1;
    *(uint4*)(sK + (krow_ + 32) * 136 + kkc * 8) = rk2; *(uint4*)(sK + (krow_ + 48) * 136 + kkc * 8) = rk3;
    ST_V(vrow, rv0) ST_V(vrow + 32, rv1) ST_V(vrow + 64, rv2) ST_V(vrow + 96, rv3)
    __syncthreads();
    if (kt > 0) SB_LOAD(kt - 1)
#pragma unroll 1
    for (int sub = 1; sub >= 0; --sub) {
      const int ks = kt * 64 + sub * 32;
      if (ks >= qs + 31) continue;
      f32x16 S;
#pragma unroll
      for (int i = 0; i < 16; ++i) S[i] = 0.f;
#pragma unroll
      for (int kk = 0; kk < 8; ++kk) {
        bf16x8 kf = *(const bf16x8*)(sK + (sub * 32 + r) * 136 + kk * 16 + hh * 8);
        S = MFMA(kf, qf[kk], S);
      }
      const bool diag = (ks + 31 >= qs);
      const int tq = qs + r;
      float lk[16], ls[16];
#pragma unroll
      for (int i = 0; i < 16; ++i) {
        float z = S[i] * SB_SCALE;
        float e = __expf(-fabsf(z));
        float l1p = __logf(1.f + e);
        ls[i] = fminf(z, 0.f) - l1p;
        lk[i] = ls[i] - z;
        if (diag) { bool valid = (ks + crow(i, hh)) < tq; if (!valid) { lk[i] = 0.f; ls[i] = -1e30f; } }
      }
      float own[4], oth[4];
#pragma unroll
      for (int gq = 0; gq < 4; ++gq) own[gq] = (lk[4 * gq] + lk[4 * gq + 1]) + (lk[4 * gq + 2] + lk[4 * gq + 3]);
#pragma unroll
      for (int gq = 0; gq < 4; ++gq) oth[gq] = __shfl_xor(own[gq], 32);
      float sg = cy;
      float w[16];
#pragma unroll
      for (int gq = 3; gq >= 0; --gq) {
        float run = sg + (hh == 0 ? oth[gq] : 0.f);
#pragma unroll
        for (int j = 3; j >= 0; --j) { w[4 * gq + j] = __expf(ls[4 * gq + j] + run); run += lk[4 * gq + j]; }
        sg += own[gq] + oth[gq];
      }
      cy = sg;
#pragma unroll
      for (int s = 0; s < 2; ++s) {
        uint4 pk;
        pk.x = pack2(w[8 * s + 0], w[8 * s + 1]); pk.y = pack2(w[8 * s + 2], w[8 * s + 3]);
        pk.z = pack2(w[8 * s + 4], w[8 * s + 5]); pk.w = pack2(w[8 * s + 6], w[8 * s + 7]);
        bf16x8 pf = __builtin_bit_cast(bf16x8, pk);
#pragma unroll
        for (int dt = 0; dt < 4; ++dt) {
          const bf16_t* vp = sV + (dt * 32 + r) * 68 + sub * 32 + 16 * s + 4 * hh;
          uint2 lo = *(const uint2*)vp, hi = *(const uint2*)(vp + 8);
          uint4 vv = make_uint4(lo.x, lo.y, hi.x, hi.y);
          o[dt] = MFMA(__builtin_bit_cast(bf16x8, vv), pf, o[dt]);
        }
      }
    }
  }
#pragma unroll
  for (int dt = 0; dt < 4; ++dt)
#pragma unroll
    for (int gq = 0; gq < 4; ++gq) {
      float ov[4] = {o[dt][4 * gq], o[dt][4 * gq + 1], o[dt][4 * gq + 2], o[dt][4 * gq + 3]};
      store4bf(Yb + (long)(qs + r) * NIN + C_SBQ + hd * 128 + dt * 32 + 8 * gq + 4 * hh, ov);
    }
#else
  const bf16_t* Vg = p->vtb + (long)(b * 8 + hd) * 128 * SEQ;
  for (int ri = 0; ri < 32; ++ri) {
    const int t = qs + ri;
    unsigned qq = *(const unsigned*)(Yb + (long)t * NIN + C_SBQ + hd * 128 + 2 * lane);
    const float q0 = bflo(qq), q1 = bfhi(qq);
    float o0 = 0.f, o1 = 0.f, cyv = 0.f;
    for (int s = t - 1; s >= 0; --s) {
      unsigned kk2 = *(const unsigned*)(Yb + (long)s * NIN + C_SBK + hd * 128 + 2 * lane);
      float part = q0 * bflo(kk2) + q1 * bfhi(kk2);
#pragma unroll
      for (int of = 32; of >= 1; of >>= 1) part += __shfl_xor(part, of);
      float z = part * SB_SCALE;
      float lsg = fminf(z, 0.f) - log1pf(expf(-fabsf(z)));
      float wgt = expf(lsg + cyv);
      cyv += lsg - z;
      float v0 = bf2f(Vg[(long)(2 * lane) * SEQ + s]), v1 = bf2f(Vg[(long)(2 * lane + 1) * SEQ + s]);
      o0 += wgt * v0; o1 += wgt * v1;
    }
    *(unsigned*)(Yb + (long)t * NIN + C_SBQ + hd * 128 + 2 * lane) = pack2(o0, o1);
  }
#endif
}

DI void mla_item(int item, char* smem) {
  PP p = get_params();
  const int qblk = 31 - (item >> 5), bh = item & 31, b = bh >> 3, hd = bh & 7;
  const int tid = otid(), lane = tid & 63, wave = tid >> 6, r = lane & 31, hh = lane >> 5;
  const int qs = qblk * 128 + wave * 32;
  const bf16_t* Qg = p->qb + (long)b * SEQ * 1536 + hd * 192;
  const bf16_t* Kn = p->kb + (long)b * SEQ * 1024 + hd * 128;
  const bf16_t* Kr = p->Y + (long)b * SEQ * NIN + C_KR;
  const bf16_t* Vg = p->vtc + (long)(b * 8 + hd) * 128 * SEQ;
  bf16_t* Og = p->hb + (long)b * SEQ * 1024 + hd * 128;
#if !NAIVE_ATTN
  bf16_t* sK = (bf16_t*)smem;
  bf16_t* sR = sK + 64 * 136;
  bf16_t* sV = sR + 64 * 72;
  bf16x8 qf[12];
#pragma unroll
  for (int kk = 0; kk < 12; ++kk) qf[kk] = *(const bf16x8*)(Qg + (long)(qs + r) * 1536 + kk * 16 + hh * 8);
  f32x16 o[4];
#pragma unroll
  for (int dt = 0; dt < 4; ++dt)
#pragma unroll
    for (int i = 0; i < 16; ++i) o[dt][i] = 0.f;
  float mrun = -1e30f, lrun = 0.f;
  const int nt_blk = qblk * 2 + 2, nt_w = (qs >> 6) + 1;
  const int krow_ = tid >> 4, kkc = tid & 15, vrow = tid >> 3, vkc = tid & 7;
  uint4 rk0, rk1, rk2, rk3, rv0, rv1, rv2, rv3, rr0, rr1;
  const bf16_t* kgp = Kn + (long)krow_ * 1024 + kkc * 8;
  const bf16_t* vgp = Vg + (long)vrow * SEQ + vkc * 8;
  const bf16_t* rgp = Kr + (long)vrow * NIN + vkc * 8;
#define MLA_LOAD(KT) { const bf16_t* kq = kgp + (long)((KT) * 64) * 1024; const bf16_t* vq = vgp + (KT) * 64; const bf16_t* rq = rgp + (long)((KT) * 64) * NIN; \
    rk0 = *(const uint4*)(kq); rk1 = *(const uint4*)(kq + 16L * 1024); rk2 = *(const uint4*)(kq + 32L * 1024); rk3 = *(const uint4*)(kq + 48L * 1024); \
    rv0 = *(const uint4*)(vq); rv1 = *(const uint4*)(vq + 32L * SEQ); rv2 = *(const uint4*)(vq + 64L * SEQ); rv3 = *(const uint4*)(vq + 96L * SEQ); \
    rr0 = *(const uint4*)(rq); rr1 = *(const uint4*)(rq + 32L * NIN); }
  MLA_LOAD(0)
  for (int kt = 0; kt < nt_blk; ++kt) {
    __syncthreads();
    *(uint4*)(sK + (krow_) * 136 + kkc * 8) = rk0; *(uint4*)(sK + (krow_ + 16) * 136 + kkc * 8) = rk1;
    *(uint4*)(sK + (krow_ + 32) * 136 + kkc * 8) = rk2; *(uint4*)(sK + (krow_ + 48) * 136 + kkc * 8) = rk3;
    ST_V(vrow, rv0) ST_V(vrow + 32, rv1) ST_V(vrow + 64, rv2) ST_V(vrow + 96, rv3)
    *(uint4*)(sR + (vrow) * 72 + vkc * 8) = rr0; *(uint4*)(sR + (vrow + 32) * 72 + vkc * 8) = rr1;
    __syncthreads();
    if (kt + 1 < nt_blk) MLA_LOAD(kt + 1)
    if (kt < nt_w) {
      f32x16 S[2];
#pragma unroll
      for (int sub = 0; sub < 2; ++sub) {
#pragma unroll
        for (int i = 0; i < 16; ++i) S[sub][i] = 0.f;
#pragma unroll
        for (int kk = 0; kk < 8; ++kk) {
          bf16x8 kf = *(const bf16x8*)(sK + (sub * 32 + r) * 136 + kk * 16 + hh * 8);
          S[sub] = MFMA(kf, qf[kk], S[sub]);
        }
#pragma unroll
        for (int kk = 0; kk < 4; ++kk) {
          bf16x8 kf = *(const bf16x8*)(sR + (sub * 32 + r) * 72 + kk * 16 + hh * 8);
          S[sub] = MFMA(kf, qf[8 + kk], S[sub]);
        }
      }
      float mx = -1e30f;
#pragma unroll
      for (int sub = 0; sub < 2; ++sub)
#pragma unroll
        for (int i = 0; i < 16; ++i) mx = fmaxf(mx, S[sub][i]);
      mx = fmaxf(mx, __shfl_xor(mx, 32));
      const float mnew = fmaxf(mrun, mx * MLA_SCALE);
      const float alpha = __expf(mrun - mnew);
      mrun = mnew;
      float psum = 0.f;
#pragma unroll
      for (int sub = 0; sub < 2; ++sub)
#pragma unroll
        for (int i = 0; i < 16; ++i) { float pv = __expf(S[sub][i] * MLA_SCALE - mnew); S[sub][i] = pv; psum += pv; }
      lrun = lrun * alpha + psum;
#pragma unroll
      for (int dt = 0; dt < 4; ++dt)
#pragma unroll
        for (int i = 0; i < 16; ++i) o[dt][i] *= alpha;
#pragma unroll
      for (int sub = 0; sub < 2; ++sub)
#pragma unroll
        for (int s = 0; s < 2; ++s) {
          uint4 pk;
          pk.x = pack2(S[sub][8 * s + 0], S[sub][8 * s + 1]); pk.y = pack2(S[sub][8 * s + 2], S[sub][8 * s + 3]);
          pk.z = pack2(S[sub][8 * s + 4], S[sub][8 * s + 5]); pk.w = pack2(S[sub][8 * s + 6], S[sub][8 * s + 7]);
          bf16x8 pf = __builtin_bit_cast(bf16x8, pk);
#pragma unroll
          for (int dt = 0; dt < 4; ++dt) {
            const bf16_t* vp = sV + (dt * 32 + r) * 68 + sub * 32 + 16 * s + 4 * hh;
            uint2 lo = *(const uint2*)vp, hi = *(const uint2*)(vp + 8);
            uint4 vv = make_uint4(lo.x, lo.y, hi.x, hi.y);
            o[dt] = MFMA(__builtin_bit_cast(bf16x8, vv), pf, o[dt]);
          }
        }
    }
  }
  const float ltot = lrun + __shfl_xor(lrun, 32);
  const float linv = 1.f / ltot;
#pragma unroll
  for (int dt = 0; dt < 4; ++dt)
#pragma unroll
    for (int gq = 0; gq < 4; ++gq) {
      float ov[4] = {o[dt][4 * gq] * linv, o[dt][4 * gq + 1] * linv, o[dt][4 * gq + 2] * linv, o[dt][4 * gq + 3] * linv};
      store4bf(Og + (long)(qs + r) * 1024 + dt * 32 + 8 * gq + 4 * hh, ov);
    }
#else
  for (int ri = 0; ri < 32; ++ri) {
    const int t = qs + ri;
    unsigned qq = *(const unsigned*)(Qg + (long)t * 1536 + 2 * lane);
    const float q0 = bflo(qq), q1 = bfhi(qq), q2 = bf2f(Qg[(long)t * 1536 + 128 + lane]);
    float o0 = 0.f, o1 = 0.f, mr = -1e30f, lr = 0.f;
    const int kend = ((t >> 6) + 1) * 64;
    for (int s = 0; s < kend; ++s) {
      unsigned kk2 = *(const unsigned*)(Kn + (long)s * 1024 + 2 * lane);
      float part = q0 * bflo(kk2) + q1 * bfhi(kk2) + q2 * bf2f(Kr[(long)s * NIN + lane]);
#pragma unroll
      for (int of = 32; of >= 1; of >>= 1) part += __shfl_xor(part, of);
      float sc = part * MLA_SCALE;
      float mn = fmaxf(mr, sc), al = expf(mr - mn), pv = expf(sc - mn);
      mr = mn; lr = lr * al + pv;
      float v0 = bf2f(Vg[(long)(2 * lane) * SEQ + s]), v1 = bf2f(Vg[(long)(2 * lane + 1) * SEQ + s]);
      o0 = o0 * al + pv * v0; o1 = o1 * al + pv * v1;
    }
    *(unsigned*)(Og + (long)t * 1024 + 2 * lane) = pack2(o0 / lr, o1 / lr);
  }
#endif
}

DI void mla_rinv(const bf16_t* A, int m0, float* rinv) {
  const int tid = otid(), row = tid >> 1, half = tid & 1;
  const bf16_t* ap = A + (long)(m0 + row) * NIN + half * 128;
  float ss = 0.f;
#pragma unroll 4
  for (int i = 0; i < 16; ++i) {
    uint4 v = *(const uint4*)(ap + i * 8);
    float a0 = bflo(v.x), a1 = bfhi(v.x), a2 = bflo(v.y), a3 = bfhi(v.y), a4 = bflo(v.z), a5 = bfhi(v.z), a6 = bflo(v.w), a7 = bfhi(v.w);
    ss += a0 * a0 + a1 * a1 + a2 * a2 + a3 * a3 + a4 * a4 + a5 * a5 + a6 * a6 + a7 * a7;
  }
  ss += __shfl_xor(ss, 1);
  __syncthreads();
  if (half == 0) rinv[row] = rsqrtf(ss * (1.f / 256.f) + 1e-6f);
  __syncthreads();
}

DI void mla_up_item(int l, int idx, bool isq, char* smem) {
  PP p = get_params();
  float* rinv = (float*)(smem + SMEM_RINV);
  GemmSpec g;
  int mt, nt;
  if (isq) { mt = idx / 12; nt = idx - mt * 12; g.A = p->Y + C_CQ; g.Bt = p->wb + W_UQ; g.Nv = 1536; g.W = (const float*)p->in[15] + (long)l * 256 * 1536; g.ldw = 1536; g.kscale = (const float*)p->in[14] + l * 256; }
  else { mt = idx >> 4; nt = idx & 15; g.A = p->Y + C_CKV; g.Bt = p->wb + W_UKV; g.Nv = 2048; g.W = (const float*)p->in[17] + (long)l * 256 * 2048; g.ldw = 2048; g.kscale = (const float*)p->in[16] + l * 256; }
  g.lda = NIN; g.K = 256; g.mapmode = 0;
  const int m0 = mt * 128, n0 = nt * 128;
  mla_rinv(g.A, m0, rinv);
  f32x16 acc[2][2];
  gemm_main<2>(g, m0, n0, acc, smem);
  if (isq) { EpiQ e{p->qb, rinv, m0, p->cosb, p->sinb}; gemm_epi(acc, m0, n0, g.Nv, e); }
  else { EpiKV e{p->kb, p->vtc, rinv, m0}; gemm_epi(acc, m0, n0, g.Nv, e); }
}

DI int next_item(int* ctr, char* smem) {
  int* sh = (int*)(smem + SMEM_ITEM);
  __syncthreads();
  if (otid() == 0) *sh = atomicAdd(ctr, 1);
  __syncthreads();
  return *sh;
}

DI void run_phase(int ph, char* smem) {
  PP p = get_params();
  if (ph == 0) {
    if (!EN(15)) return;
    const float4* xin = (const float4*)p->in[0];
    float4* xo = (float4*)p->xres;
    const long n4 = (long)T_TOK * DM / 4;
    for (long i = (long)blockIdx.x * 256 + otid(); i < n4; i += (long)gridDim.x * 256) xo[i] = xin[i];
    const int* pos = (const int*)p->in[1];
    for (int i = blockIdx.x * 256 + otid(); i < T_TOK * 32; i += gridDim.x * 256) {
      int tok = i >> 5, f = i & 31;
      float inv = (float)exp(-(double)(2 * f) / 64.0 * 9.210340371976184);
      float ang = (float)pos[tok] * inv;
      p->cosb[i] = cosf(ang); p->sinb[i] = sinf(ang);
    }
    return;
  }
  if (ph == NPH - 1) { if (EN(15)) norm_phase<true>(p->xres, (const float*)p->in[25], nullptr, p->xres); return; }
  const int l = (ph - 1) / 12, j = (ph - 1) % 12;
  switch (j) {
    case 0: if (EN(0)) convert_layer(l, smem); if (EN(15)) norm_phase<false>(p->xres, (const float*)p->in[2] + l * DM, p->hb, nullptr); break;
    case 1: case 10: if (EN(1)) {
      GemmSpec g; g.A = p->hb; g.lda = 1024; g.Bt = p->wb + (j == 1 ? W_GU1 : W_GU2); g.K = 1024; g.Nv = 5632;
      g.W = (const float*)p->in[j == 1 ? 3 : 23] + (long)l * 1024 * 5632; g.ldw = 5632; g.mapmode = 1; g.kscale = nullptr;
      EpiSwiglu e{p->Y};
      gemm_phase(g, e, smem);
    } break;
    case 2: case 11: if (EN(2)) {
      GemmSpec g; g.A = p->Y; g.lda = DFF; g.Bt = p->wb + (j == 2 ? W_D1 : W_D2); g.K = DFF; g.Nv = 1024;
      g.W = (const float*)p->in[j == 2 ? 4 : 24] + (long)l * 2816 * 1024; g.ldw = 1024; g.mapmode = 0; g.kscale = nullptr;
      EpiResid e{p->xres, 0.5f};
      gemm_phase(g, e, smem);
    } break;
    case 3: if (EN(15)) norm_phase<false>(p->xres, (const float*)p->in[5] + l * DM, p->hb, nullptr); break;
    case 4: if (EN(4)) {
      GemmSpec g; g.A = p->hb; g.lda = 1024; g.Bt = p->wb + W_IN; g.K = 1024; g.Nv = NIN;
      g.W = (const float*)p->in[6] + (long)l * 1024 * NIN; g.ldw = NIN; g.mapmode = 0; g.kscale = nullptr;
      EpiWin e{p->Y, p->vtb, p->cosb, p->sinb};
      gemm_phase(g, e, smem);
    } break;
    case 5: {
      int* ctr = p->counters + ph;
      for (;;) {
        int it = next_item(ctr, smem);
        if (it >= 64 + 1024 + 1536 + 2048) break;
        if (it < 64) { if (EN(12)) rg_item(l, it, smem); }
        else if (it < 64 + 1024) { if (EN(13)) sb_item(it - 64, smem); }
        else if (it < 64 + 1024 + 1536) { if (EN(14)) mla_up_item(l, it - 1088, true, smem); }
        else { if (EN(14)) mla_up_item(l, it - 2624, false, smem); }
      }
    } break;
    case 6: {
      int* ctr = p->counters + ph;
      for (;;) {
        int it = next_item(ctr, smem);
        if (it >= 1024) break;
        if (EN(6)) mla_item(it, smem);
      }
    } break;
    case 7: if (EN(7)) merge_phase(l, smem); break;
    case 8: if (EN(8)) {
      GemmSpec g; g.A = p->qb; g.lda = 1024; g.Bt = p->wb + W_OUT; g.K = 1024; g.Nv = 1024;
      g.W = (const float*)p->in[21] + (long)l * 1048576; g.ldw = 1024; g.mapmode = 0; g.kscale = nullptr;
      EpiResid e{p->xres, 1.0f};
      gemm_phase(g, e, smem);
    } break;
    case 9: if (EN(15)) norm_phase<false>(p->xres, (const float*)p->in[22] + l * DM, p->hb, nullptr); break;
  }
}

__global__ void __launch_bounds__(256, 2) mega(Params p) {
  extern __shared__ __attribute__((aligned(16))) char smem[];
  for (int ph = p.ph_lo; ph < p.ph_hi; ++ph) {
    run_phase(ph, smem);
    if (ph + 1 < p.ph_hi) cg::this_grid().sync();
  }
}

extern "C" void kernel_launch(void* const* d_in, const int* in_sizes, int n_in, void* d_out, int out_size, void* d_ws, size_t ws_size, hipStream_t stream) {
  static int grid = 0;
  if (!grid) {
    int dev = 0, cus = 0, per_cu = 0;
    hipGetDevice(&dev);
    hipDeviceGetAttribute(&cus, hipDeviceAttributeMultiprocessorCount, dev);
    hipFuncSetAttribute((const void*)mega, hipFuncAttributeMaxDynamicSharedMemorySize, SMEM_BYTES);
    hipOccupancyMaxActiveBlocksPerMultiprocessor(&per_cu, (const void*)mega, 256, SMEM_BYTES);
    if (per_cu < 1) per_cu = 1;
    if (per_cu > 2) per_cu = 2;
    grid = cus * per_cu;
  }
  char* ws = (char*)d_ws;
  size_t off = 0;
  auto take = [&](size_t bytes) { char* q = ws + off; off += (bytes + 255) & ~(size_t)255; return q; };
  Params p{};
  for (int i = 0; i < 26; ++i) p.in[i] = d_in[i];
  p.xres = (float*)d_out;
  p.counters = (int*)take(4096);
  p.cosb = (float*)take((size_t)T_TOK * 32 * 4);
  p.sinb = (float*)take((size_t)T_TOK * 32 * 4);
  p.wb = (bf16_t*)take((size_t)W_TOTAL * 2);
  p.hb = (bf16_t*)take((size_t)T_TOK * 1024 * 2);
  p.Y = (bf16_t*)take((size_t)T_TOK * NIN * 2);
  p.qb = (bf16_t*)take((size_t)T_TOK * 1536 * 2);
  p.kb = (bf16_t*)take((size_t)T_TOK * 1024 * 2);
  p.vtc = (bf16_t*)take((size_t)T_TOK * 1024 * 2);
  p.vtb = (bf16_t*)take((size_t)T_TOK * 1024 * 2);
  if (off > ws_size) { fprintf(stderr, "kernel_launch: workspace too small: need %zu have %zu\n", off, ws_size); return; }
  hipMemsetAsync(p.counters, 0, 4096, stream);
#if SINGLE_LAUNCH
  p.ph_lo = 0; p.ph_hi = NPH;
  void* args[] = {&p};
  hipError_t e = hipLaunchCooperativeKernel((const void*)mega, dim3(grid), dim3(256), args, SMEM_BYTES, stream);
  if (e != hipSuccess) fprintf(stderr, "cooperative launch failed: %s (grid %d)\n", hipGetErrorString(e), grid);
#else
  for (int ph = 0; ph < NPH; ++ph) {
    p.ph_lo = ph; p.ph_hi = ph + 1;
    hipLaunchKernelGGL(mega, dim3(grid), dim3(256), SMEM_BYTES, stream, p);
  }
#endif
}
```

```cpp
#include <hip/hip_runtime.h>
#include <hip/hip_cooperative_groups.h>
#include <stdint.h>
#include <stdio.h>
namespace cg = cooperative_groups;

#ifndef NAIVE_GEMM
#define NAIVE_GEMM 0
#endif
#ifndef NAIVE_ATTN
#define NAIVE_ATTN 0
#endif
#ifndef NAIVE_RG
#define NAIVE_RG 0
#endif
#ifndef PH_MASK
#define PH_MASK 0xFFFFF
#endif
#define EN(j) ((PH_MASK >> (j)) & 1)
#ifndef REP_FFN
#define REP_FFN 1
#endif
#ifndef REP_WIN
#define REP_WIN 1
#endif
#ifndef REP_MO
#define REP_MO 1
#endif
#ifndef REP_SB
#define REP_SB 1
#endif
#ifndef REP_RG
#define REP_RG 1
#endif
#ifndef REP_UP
#define REP_UP 1
#endif
#ifndef REP_MLA
#define REP_MLA 1
#endif
#ifndef REP_NORM
#define REP_NORM 1
#endif
#ifndef PROBE
#define PROBE 0
#endif
#ifndef SINGLE_LAUNCH
#define SINGLE_LAUNCH 1
#endif

#define DI __device__ __forceinline__
typedef unsigned short bf16_t;
typedef __attribute__((ext_vector_type(8))) short bf16x8;
typedef __attribute__((ext_vector_type(16))) float f32x16;
typedef __attribute__((ext_vector_type(2))) __bf16 bf2v;
typedef __attribute__((ext_vector_type(2))) float f2v;
#define MFMA(a, b, c) __builtin_amdgcn_mfma_f32_32x32x16_bf16((a), (b), (c), 0, 0, 0)

constexpr int T_TOK = 16384, DM = 1024, SEQ = 4096, NBATCH = 4, DFF = 2816, NIN = 8768, DEPTH = 4;
constexpr int C_RGX = 0, C_RGG = 1024, C_SBQ = 2048, C_SBK = 3072, C_SBV = 4096, C_CQ = 5120, C_CKV = 5376, C_KR = 5632, C_GATE = 5696;
constexpr long W_GU1 = 0;
constexpr long W_D1 = W_GU1 + 5632L * 1024;
constexpr long W_IN = W_D1 + 1024L * 2816;
constexpr long W_UQ = W_IN + 8768L * 1024;
constexpr long W_UKV = W_UQ + 1536L * 256;
constexpr long W_BA = W_UKV + 2048L * 256;
constexpr long W_BB = W_BA + 1024L * 1024;
constexpr long W_BC = W_BB + 1024L * 1024;
constexpr long W_OUT = W_BC + 1024L * 1024;
constexpr long W_GU2 = W_OUT + 1024L * 1024;
constexpr long W_D2 = W_GU2 + 5632L * 1024;
constexpr long W_RGA = W_D2 + 1024L * 2816;
constexpr long W_RGX = W_RGA + 65536;
constexpr long W_TOTAL = W_RGX + 65536;

constexpr int NPH = 50;
constexpr int SMEM_GEMM = 2 * 2 * 128 * 72 * 2;
constexpr int SMEM_RINV = SMEM_GEMM;
constexpr int SMEM_ITEM = SMEM_GEMM + 512;
constexpr int SMEM_BYTES = SMEM_GEMM + 512 + 64;

struct Params {
  const void* in[26];
  float* xres;
  bf16_t* wb;
  bf16_t* hb;
  bf16_t* Y;
  bf16_t* qb;
  bf16_t* kb;
  bf16_t* vtc;
  bf16_t* vtb;
  float* cosb;
  float* sinb;
  int* counters;
  float* rgsum;
  int ph_lo, ph_hi;
};

typedef const Params __attribute__((address_space(4)))* PP;
__device__ __forceinline__ PP get_params() { PP q = (PP)__builtin_amdgcn_kernarg_segment_ptr(); asm volatile("" : "+s"(q)); return q; }
__device__ __forceinline__ int otid() { int t = threadIdx.x; asm volatile("" : "+v"(t)); return t; }
DI unsigned pack2(float a, float b) { f2v v = {a, b}; bf2v r = __builtin_convertvector(v, bf2v); return __builtin_bit_cast(unsigned, r); }
DI bf16_t f2bf(float a) { return (bf16_t)(pack2(a, 0.f) & 0xffffu); }
DI float bf2f(bf16_t v) { return __uint_as_float(((unsigned)v) << 16); }
DI float bflo(unsigned u) { return __uint_as_float(u << 16); }
DI float bfhi(unsigned u) { return __uint_as_float(u & 0xffff0000u); }
DI int crow(int i, int h) { return (i & 3) + 8 * (i >> 2) + 4 * h; }
DI float sigmoidf_(float x) { return 1.f / (1.f + __expf(-x)); }
DI float gelu_tanh(float x) { float u = 0.7978845608028654f * (x + 0.044715f * x * x * x); return x / (1.f + __expf(-2.f * u)); }
DI void store4bf(bf16_t* p, const float (&v)[4]) { uint2 u; u.x = pack2(v[0], v[1]); u.y = pack2(v[2], v[3]); *(uint2*)p = u; }

struct GemmSpec {
  const bf16_t* A; int lda;
  const bf16_t* Bt; int K;
  int Nv;
  const float* W; int ldw;
  int mapmode;
  const float* kscale;
};
DI int wcol(int mode, int n) {
  if (mode == 0) return n;
  int blk = n >> 6, which = (n >> 5) & 1, j = blk * 32 + (n & 31);
  return which * DFF + j;
}

constexpr int LROW = 72;

template <int NI, int DEPTH, int PIPE = 1>
DI void gemm_main(const GemmSpec& g, int m0, int n0, f32x16 (&acc)[2][NI], char* smem) {
  const int tid = otid(), lane = tid & 63, wave = tid >> 6;
  const int r = lane & 31, hh = lane >> 5, wm = wave >> 1, wn = wave & 1;
#pragma unroll
  for (int a = 0; a < 2; ++a)
#pragma unroll
    for (int b = 0; b < NI; ++b)
#pragma unroll
      for (int i = 0; i < 16; ++i) acc[a][b][i] = 0.f;
  __syncthreads();
#if !NAIVE_GEMM
  bf16_t* sA = (bf16_t*)smem;
  bf16_t* sB = sA + 2 * 128 * LROW;
  const int srow = tid >> 3, skc = tid & 7;
  const bf16_t* Ap = g.A + (long)(m0 + srow) * g.lda + skc * 8;
  const bf16_t* Bp0 = g.Bt + (long)(n0 + srow) * g.K + skc * 8;
  const long ldb32 = (long)32 * g.K;
  const long lda32 = (long)32 * g.lda;
  uint4 a00, a01, a02, a03, b00, b01, b02, b03, a10, a11, a12, a13, b10, b11, b12, b13, a20, a21, a22, a23, b20, b21, b22, b23;
  b02 = b03 = b12 = b13 = b22 = b23 = make_uint4(0u, 0u, 0u, 0u);
  const int KT = g.K >> 6;
  bf16_t* wA = sA + srow * LROW + skc * 8;
  bf16_t* wB = sB + srow * LROW + skc * 8;
#define G_LOAD(S, KTILE) { const int ko = (KTILE) * 64; \
    a##S##0 = *(const uint4*)(Ap + ko); a##S##1 = *(const uint4*)(Ap + lda32 + ko); a##S##2 = *(const uint4*)(Ap + 2 * lda32 + ko); a##S##3 = *(const uint4*)(Ap + 3 * lda32 + ko); \
    b##S##0 = *(const uint4*)(Bp0 + ko); b##S##1 = *(const uint4*)(Bp0 + ldb32 + ko); \
    if (NI == 2) { b##S##2 = *(const uint4*)(Bp0 + 2 * ldb32 + ko); b##S##3 = *(const uint4*)(Bp0 + 3 * ldb32 + ko); } }
#define G_STORE(S, BUF) { bf16_t* pa = wA + (BUF) * 128 * LROW; bf16_t* pb = wB + (BUF) * (64 * NI) * LROW; \
    *(uint4*)(pa) = a##S##0; *(uint4*)(pa + 32 * LROW) = a##S##1; *(uint4*)(pa + 64 * LROW) = a##S##2; *(uint4*)(pa + 96 * LROW) = a##S##3; \
    *(uint4*)(pb) = b##S##0; *(uint4*)(pb + 32 * LROW) = b##S##1; \
    if (NI == 2) { *(uint4*)(pb + 64 * LROW) = b##S##2; *(uint4*)(pb + 96 * LROW) = b##S##3; } }
#define G_FRAGS(KK, BF, AF) { \
    _Pragma("unroll") for (int ni = 0; ni < NI; ++ni) BF[ni] = *(const bf16x8*)(cB + ni * 32 * LROW + (KK) * 16); \
    _Pragma("unroll") for (int mi = 0; mi < 2; ++mi) AF[mi] = *(const bf16x8*)(cA + mi * 32 * LROW + (KK) * 16); }
#define G_MMA(BF, AF) { \
    __builtin_amdgcn_s_setprio(1); \
    _Pragma("unroll") for (int mi = 0; mi < 2; ++mi) \
      _Pragma("unroll") for (int ni = 0; ni < NI; ++ni) acc[mi][ni] = MFMA(BF[ni], AF[mi], acc[mi][ni]); \
    __builtin_amdgcn_s_setprio(0); \
    __builtin_amdgcn_sched_barrier(0); }
#define G_COMPUTE(BUF) { \
    const bf16_t* cA = sA + (BUF) * 128 * LROW + (wm * 64 + r) * LROW + hh * 8; \
    const bf16_t* cB = sB + (BUF) * (64 * NI) * LROW + (wn * 32 * NI + r) * LROW + hh * 8; \
    bf16x8 bf0[NI], af0[2], bf1[NI], af1[2]; \
    G_FRAGS(0, bf0, af0) \
    G_FRAGS(1, bf1, af1) \
    __builtin_amdgcn_sched_barrier(0); \
    G_MMA(bf0, af0) \
    G_FRAGS(2, bf0, af0) \
    __builtin_amdgcn_sched_barrier(0); \
    G_MMA(bf1, af1) \
    G_FRAGS(3, bf1, af1) \
    __builtin_amdgcn_sched_barrier(0); \
    G_MMA(bf0, af0) \
    G_MMA(bf1, af1) }
#define G_COMPUTE_SIMPLE(BUF) { \
    const bf16_t* cA = sA + (BUF) * 128 * LROW + (wm * 64 + r) * LROW + hh * 8; \
    const bf16_t* cB = sB + (BUF) * (64 * NI) * LROW + (wn * 32 * NI + r) * LROW + hh * 8; \
    _Pragma("unroll") for (int kk = 0; kk < 4; ++kk) { \
      bf16x8 bfr[NI], afr[2]; \
      _Pragma("unroll") for (int ni = 0; ni < NI; ++ni) bfr[ni] = *(const bf16x8*)(cB + ni * 32 * LROW + kk * 16); \
      _Pragma("unroll") for (int mi = 0; mi < 2; ++mi) afr[mi] = *(const bf16x8*)(cA + mi * 32 * LROW + kk * 16); \
      _Pragma("unroll") for (int mi = 0; mi < 2; ++mi) \
        _Pragma("unroll") for (int ni = 0; ni < NI; ++ni) acc[mi][ni] = MFMA(bfr[ni], afr[mi], acc[mi][ni]); \
    } }
#define G_COMPUTE_ST(BUF, S, NB, DO, DOL, KL) { \
    const bf16_t* cA = sA + (BUF) * 128 * LROW + (wm * 64 + r) * LROW + hh * 8; \
    const bf16_t* cB = sB + (BUF) * (64 * NI) * LROW + (wn * 32 * NI + r) * LROW + hh * 8; \
    bf16_t* pa = wA + (NB) * 128 * LROW; bf16_t* pb = wB + (NB) * (64 * NI) * LROW; \
    const int ko = (KL) * 64; \
    bf16x8 bf0[NI], af0[2], bf1[NI], af1[2], bf2[NI], af2[2]; \
    G_FRAGS(0, bf0, af0) \
    G_FRAGS(1, bf1, af1) \
    G_FRAGS(2, bf2, af2) \
    __builtin_amdgcn_sched_barrier(0); \
    G_MMA(bf0, af0) \
    G_FRAGS(3, bf0, af0) \
    if (DO) { *(uint4*)(pa) = a##S##0; } \
    if (DOL) { a##S##0 = *(const uint4*)(Ap + ko); } \
    __builtin_amdgcn_sched_barrier(0); \
    G_MMA(bf1, af1) \
    if (DO) { *(uint4*)(pa + 32 * LROW) = a##S##1; *(uint4*)(pa + 64 * LROW) = a##S##2; } \
    if (DOL) { a##S##1 = *(const uint4*)(Ap + lda32 + ko); a##S##2 = *(const uint4*)(Ap + 2 * lda32 + ko); } \
    __builtin_amdgcn_sched_barrier(0); \
    G_MMA(bf2, af2) \
    if (DO) { *(uint4*)(pa + 96 * LROW) = a##S##3; *(uint4*)(pb) = b##S##0; } \
    if (DOL) { a##S##3 = *(const uint4*)(Ap + 3 * lda32 + ko); b##S##0 = *(const uint4*)(Bp0 + ko); } \
    __builtin_amdgcn_sched_barrier(0); \
    G_MMA(bf0, af0) \
    if (DO) { *(uint4*)(pb + 32 * LROW) = b##S##1; if (NI == 2) { *(uint4*)(pb + 64 * LROW) = b##S##2; *(uint4*)(pb + 96 * LROW) = b##S##3; } } \
    if (DOL) { b##S##1 = *(const uint4*)(Bp0 + ldb32 + ko); if (NI == 2) { b##S##2 = *(const uint4*)(Bp0 + 2 * ldb32 + ko); b##S##3 = *(const uint4*)(Bp0 + 3 * ldb32 + ko); } } \
    __builtin_amdgcn_sched_barrier(0); }
#define G_COMPUTE_ST1(BUF, S, NB, DO, DOL, KL) { \
    const bf16_t* cA = sA + (BUF) * 128 * LROW + (wm * 64 + r) * LROW + hh * 8; \
    const bf16_t* cB = sB + (BUF) * (64 * NI) * LROW + (wn * 32 * NI + r) * LROW + hh * 8; \
    bf16_t* pa = wA + (NB) * 128 * LROW; bf16_t* pb = wB + (NB) * (64 * NI) * LROW; \
    const int ko = (KL) * 64; \
    bf16x8 bf0[NI], af0[2]; \
    G_FRAGS(0, bf0, af0) \
    __builtin_amdgcn_sched_barrier(0); \
    G_MMA(bf0, af0) \
    G_FRAGS(1, bf0, af0) \
    if (DO) { *(uint4*)(pa) = a##S##0; *(uint4*)(pa + 32 * LROW) = a##S##1; } \
    if (DOL) { a##S##0 = *(const uint4*)(Ap + ko); a##S##1 = *(const uint4*)(Ap + lda32 + ko); } \
    __builtin_amdgcn_sched_barrier(0); \
    G_MMA(bf0, af0) \
    G_FRAGS(2, bf0, af0) \
    if (DO) { *(uint4*)(pa + 64 * LROW) = a##S##2; *(uint4*)(pa + 96 * LROW) = a##S##3; } \
    if (DOL) { a##S##2 = *(const uint4*)(Ap + 2 * lda32 + ko); a##S##3 = *(const uint4*)(Ap + 3 * lda32 + ko); } \
    __builtin_amdgcn_sched_barrier(0); \
    G_MMA(bf0, af0) \
    G_FRAGS(3, bf0, af0) \
    if (DO) { *(uint4*)(pb) = b##S##0; *(uint4*)(pb + 32 * LROW) = b##S##1; } \
    if (DOL) { b##S##0 = *(const uint4*)(Bp0 + ko); b##S##1 = *(const uint4*)(Bp0 + ldb32 + ko); } \
    __builtin_amdgcn_sched_barrier(0); \
    G_MMA(bf0, af0) \
    if (NI == 2) { if (DO) { *(uint4*)(pb + 64 * LROW) = b##S##2; *(uint4*)(pb + 96 * LROW) = b##S##3; } \
                   if (DOL) { b##S##2 = *(const uint4*)(Bp0 + 2 * ldb32 + ko); b##S##3 = *(const uint4*)(Bp0 + 3 * ldb32 + ko); } } \
    __builtin_amdgcn_sched_barrier(0); }
  if (DEPTH == 3) {
  G_LOAD(0, 0)
  G_LOAD(1, 1)
  if (KT > 2) G_LOAD(2, 2)
  G_STORE(0, 0)
  if (KT > 3) G_LOAD(0, 3)
  __syncthreads();
#define G_STEP(I, SN) { if (kt + (I) >= KT) break; \
    G_COMPUTE((I) & 1) \
    if (kt + (I) + 1 < KT) { G_STORE(SN, ((I) + 1) & 1) if (kt + (I) + 4 < KT) G_LOAD(SN, kt + (I) + 4) } \
    __syncthreads(); }
  for (int kt = 0; kt < KT; kt += 6) {
    G_STEP(0, 1)
    G_STEP(1, 2)
    G_STEP(2, 0)
    G_STEP(3, 1)
    G_STEP(4, 2)
    G_STEP(5, 0)
  }
#undef G_STEP
  } else {
  G_LOAD(0, 0)
  G_LOAD(1, 1)
  G_STORE(0, 0)
  if (KT > 2) G_LOAD(0, 2)
  __syncthreads();
  for (int kt = 0; kt < KT; kt += 2) {
    const bool l3 = kt + 3 < KT, more = kt + 2 < KT, l4 = kt + 4 < KT;
    if (PIPE == 1) { G_COMPUTE_ST(0, 1, 1, true, l3, kt + 3) } else if (PIPE == 2) { G_COMPUTE_ST1(0, 1, 1, true, l3, kt + 3) } else { G_COMPUTE_SIMPLE(0) G_STORE(1, 1) if (l3) G_LOAD(1, kt + 3) }
    __syncthreads();
    if (PIPE == 1) { G_COMPUTE_ST(1, 0, 0, more, l4, kt + 4) } else if (PIPE == 2) { G_COMPUTE_ST1(1, 0, 0, more, l4, kt + 4) } else { G_COMPUTE_SIMPLE(1) if (more) G_STORE(0, 0) if (l4) G_LOAD(0, kt + 4) }
    __syncthreads();
  }
  }
#else
  float* As = (float*)smem;
  float* Ws = As + 128 * 17;
  for (int k0 = 0; k0 < g.K; k0 += 16) {
    {
      int row = tid >> 1, half = tid & 1;
      uint4 v = *(const uint4*)(g.A + (long)(m0 + row) * g.lda + k0 + half * 8);
      float* d = As + row * 17 + half * 8;
      d[0] = bflo(v.x); d[1] = bfhi(v.x); d[2] = bflo(v.y); d[3] = bfhi(v.y); d[4] = bflo(v.z); d[5] = bfhi(v.z); d[6] = bflo(v.w); d[7] = bfhi(v.w);
      int kk = tid >> 4, c8 = (tid & 15) * 4 * NI;
      float ks = g.kscale ? g.kscale[k0 + kk] : 1.f;
#pragma unroll
      for (int q = 0; q < NI; ++q) {
        int n = n0 + c8 + q * 4;
        float4 w = make_float4(0.f, 0.f, 0.f, 0.f);
        if (n < g.Nv) w = *(const float4*)(g.W + (long)(k0 + kk) * g.ldw + wcol(g.mapmode, n));
        float* dw = Ws + kk * (64 * NI) + c8 + q * 4;
        dw[0] = w.x * ks; dw[1] = w.y * ks; dw[2] = w.z * ks; dw[3] = w.w * ks;
      }
    }
    __syncthreads();
#pragma unroll 1
    for (int k = 0; k < 16; ++k) {
#pragma unroll
      for (int mi = 0; mi < 2; ++mi) {
        float a = As[(wm * 64 + mi * 32 + r) * 17 + k];
#pragma unroll
        for (int ni = 0; ni < NI; ++ni)
#pragma unroll
          for (int gq = 0; gq < 4; ++gq) {
            float4 w = *(const float4*)(Ws + k * (64 * NI) + wn * 32 * NI + ni * 32 + 8 * gq + 4 * hh);
            acc[mi][ni][4 * gq + 0] += a * w.x; acc[mi][ni][4 * gq + 1] += a * w.y; acc[mi][ni][4 * gq + 2] += a * w.z; acc[mi][ni][4 * gq + 3] += a * w.w;
          }
      }
    }
    __syncthreads();
  }
#endif
}

struct EpiDest { int type; void* base; long stride; };
constexpr int STG_F32_PITCH = 272;
constexpr int STG_WAVE = 64 * STG_F32_PITCH;
constexpr int STG_BF_PITCH = 144;
constexpr int STG_BF32_PITCH = 80;

template <class Epi>
DI void gemm_epi(f32x16 (&acc)[2][2], int m0, int n0, int Nv, Epi& epi, char* smem) {
  const int lane = otid() & 63, wave = otid() >> 6;
  const int r = lane & 31, hh = lane >> 5, wm = wave >> 1, wn = wave & 1;
  const int nw = n0 + wn * 64, mw = m0 + wm * 64;
  if (nw >= Nv) return;
  char* stg = smem + wave * STG_WAVE;
  const EpiDest d = epi.dest(mw, nw);
#pragma unroll
  for (int mi = 0; mi < 2; ++mi)
#pragma unroll
    for (int gq = 0; gq < 4; ++gq) {
      float v0[4], v1[4], o0[4], o1[4];
#pragma unroll
      for (int j = 0; j < 4; ++j) { v0[j] = acc[mi][0][4 * gq + j]; v1[j] = acc[mi][1][4 * gq + j]; }
      epi.compute(mw + mi * 32 + r, nw + 8 * gq + 4 * hh, v0, v1, o0, o1);
      const int row = mi * 32 + r, col = 8 * gq + 4 * hh;
      if (d.type == 0) {
        uint2 u0, u1; u0.x = pack2(o0[0], o0[1]); u0.y = pack2(o0[2], o0[3]); u1.x = pack2(o1[0], o1[1]); u1.y = pack2(o1[2], o1[3]);
        *(uint2*)(stg + row * STG_BF_PITCH + col * 2) = u0; *(uint2*)(stg + row * STG_BF_PITCH + (col + 32) * 2) = u1;
      } else if (d.type == 1) {
        uint2 u0; u0.x = pack2(o0[0], o0[1]); u0.y = pack2(o0[2], o0[3]);
        *(uint2*)(stg + row * STG_BF32_PITCH + col * 2) = u0;
      } else if (d.type == 2) {
#pragma unroll
        for (int j = 0; j < 4; ++j) {
          *(bf16_t*)(stg + (col + j) * STG_BF_PITCH + row * 2) = f2bf(o0[j]);
          *(bf16_t*)(stg + (col + 32 + j) * STG_BF_PITCH + row * 2) = f2bf(o1[j]);
        }
      } else {
        *(float4*)(stg + row * STG_F32_PITCH + col * 4) = make_float4(o0[0], o0[1], o0[2], o0[3]);
        *(float4*)(stg + row * STG_F32_PITCH + (col + 32) * 4) = make_float4(o1[0], o1[1], o1[2], o1[3]);
      }
    }
  __builtin_amdgcn_wave_barrier();
  asm volatile("s_waitcnt lgkmcnt(0)" ::: "memory");
  typedef unsigned v4u_t __attribute__((ext_vector_type(4)));
  const __amdgpu_buffer_rsrc_t rs = __builtin_amdgcn_make_buffer_rsrc(d.base, 0, 0x7ffffff0, 0x00020000);
  if (d.type == 0 || d.type == 2) {
    const int rr = lane >> 3, ch = lane & 7;
#pragma unroll
    for (int it = 0; it < 8; ++it) {
      const int row = it * 8 + rr;
      uint4 v = *(const uint4*)(stg + row * STG_BF_PITCH + ch * 16);
      __builtin_amdgcn_raw_buffer_store_b128(__builtin_bit_cast(v4u_t, v), rs, (unsigned)(((long)row * d.stride + ch * 8) * 2), 0, 16);
    }
  } else if (d.type == 1) {
    const int rr = lane >> 2, ch = lane & 3;
#pragma unroll
    for (int it = 0; it < 4; ++it) {
      const int row = it * 16 + rr;
      uint4 v = *(const uint4*)(stg + row * STG_BF32_PITCH + ch * 16);
      __builtin_amdgcn_raw_buffer_store_b128(__builtin_bit_cast(v4u_t, v), rs, (unsigned)(((long)row * d.stride + ch * 8) * 2), 0, 16);
    }
  } else {
    float* base = (float*)d.base;
    const int rr = lane >> 4, ch = lane & 15;
#pragma unroll
    for (int it = 0; it < 16; ++it) {
      const int row = it * 4 + rr;
      float4 sv = *(const float4*)(stg + row * STG_F32_PITCH + ch * 16);
      float4* gp = (float4*)(base + (long)row * d.stride + ch * 4);
      float4 xv = *gp;
      xv.x += sv.x; xv.y += sv.y; xv.z += sv.z; xv.w += sv.w;
      __builtin_amdgcn_raw_buffer_store_b128(__builtin_bit_cast(v4u_t, xv), rs, (unsigned)(((long)row * d.stride + ch * 4) * 4), 0, 16);
    }
  }
  __builtin_amdgcn_wave_barrier();
}

struct EpiSwiglu {
  bf16_t* act;
  DI EpiDest dest(int mw, int nw) const { return EpiDest{1, act + (long)mw * DFF + (nw >> 6) * 32, DFF}; }
  DI void compute(int, int, const float (&v0)[4], const float (&v1)[4], float (&o0)[4], float (&o1)[4]) const {
#pragma unroll
    for (int j = 0; j < 4; ++j) { o0[j] = v0[j] * sigmoidf_(v0[j]) * v1[j]; o1[j] = 0.f; }
  }
};
struct EpiResid {
  float* x; float scale;
  DI EpiDest dest(int mw, int nw) const { return EpiDest{3, x + (long)mw * DM + nw, DM}; }
  DI void compute(int, int, const float (&v0)[4], const float (&v1)[4], float (&o0)[4], float (&o1)[4]) const {
#pragma unroll
    for (int j = 0; j < 4; ++j) { o0[j] = scale * v0[j]; o1[j] = scale * v1[j]; }
  }
};
struct EpiWin {
  bf16_t* Y; bf16_t* vtb; const float* cosb; const float* sinb;
  DI EpiDest dest(int mw, int nw) const {
    if (nw >= C_SBV && nw < C_CQ) {
      const int c = nw - C_SBV, head = c >> 7, d0 = c & 127, b = mw >> 12, s0 = mw & 4095;
      return EpiDest{2, vtb + ((long)((b * 8 + head) * 128 + d0)) * SEQ + s0, SEQ};
    }
    return EpiDest{0, Y + (long)mw * NIN + nw, NIN};
  }
  DI void compute(int m, int n, const float (&v0)[4], const float (&v1)[4], float (&o0)[4], float (&o1)[4]) const {
    if ((n & ~63) == C_KR) {
      const int i0 = n - C_KR;
      float4 c = *(const float4*)(cosb + (long)m * 32 + i0), s = *(const float4*)(sinb + (long)m * 32 + i0);
      const float cc[4] = {c.x, c.y, c.z, c.w}, ss[4] = {s.x, s.y, s.z, s.w};
#pragma unroll
      for (int j = 0; j < 4; ++j) { o0[j] = v0[j] * cc[j] - v1[j] * ss[j]; o1[j] = v1[j] * cc[j] + v0[j] * ss[j]; }
    } else {
#pragma unroll
      for (int j = 0; j < 4; ++j) { o0[j] = v0[j]; o1[j] = v1[j]; }
    }
  }
};
struct EpiQ {
  bf16_t* qb; const float* rinv; int m0; const float* cosb; const float* sinb;
  DI EpiDest dest(int mw, int nw) const { return EpiDest{0, qb + (long)mw * 1536 + nw, 1536}; }
  DI void compute(int m, int n, const float (&v0)[4], const float (&v1)[4], float (&o0)[4], float (&o1)[4]) const {
    const float ri = rinv[m - m0];
    const int nb = n & ~63;
    if ((nb % 192) == 128) {
      const int i0 = n - nb;
      float4 c = *(const float4*)(cosb + (long)m * 32 + i0), s = *(const float4*)(sinb + (long)m * 32 + i0);
      const float cc[4] = {c.x, c.y, c.z, c.w}, ss[4] = {s.x, s.y, s.z, s.w};
#pragma unroll
      for (int j = 0; j < 4; ++j) { float a = v0[j] * ri, b = v1[j] * ri; o0[j] = a * cc[j] - b * ss[j]; o1[j] = b * cc[j] + a * ss[j]; }
    } else {
#pragma unroll
      for (int j = 0; j < 4; ++j) { o0[j] = v0[j] * ri; o1[j] = v1[j] * ri; }
    }
  }
};
struct EpiKV {
  bf16_t* kb; bf16_t* vtc; const float* rinv; int m0;
  DI EpiDest dest(int mw, int nw) const {
    const int head = nw >> 8, w = nw & 255;
    if (w < 128) return EpiDest{0, kb + (long)mw * 1024 + head * 128 + w, 1024};
    const int b = mw >> 12, s0 = mw & 4095;
    return EpiDest{2, vtc + ((long)((b * 8 + head) * 128 + (w - 128))) * SEQ + s0, SEQ};
  }
  DI void compute(int m, int, const float (&v0)[4], const float (&v1)[4], float (&o0)[4], float (&o1)[4]) const {
    const float ri = rinv[m - m0];
#pragma unroll
    for (int j = 0; j < 4; ++j) { o0[j] = v0[j] * ri; o1[j] = v1[j] * ri; }
  }
};

DI void conv_tile(const float* src, int ldsrc, int k0, int n0, bf16_t* dst, int ldd, int mode, const float* kscale, char* smem) {
  float* tile = (float*)smem;
  const int tid = otid();
  __syncthreads();
#pragma unroll
  for (int i = 0; i < 4; ++i) {
    int kk = (tid >> 4) + 16 * i, nn = (tid & 15) * 4;
    typedef float f4v_t __attribute__((ext_vector_type(4)));
    const f4v_t v = __builtin_nontemporal_load((const f4v_t*)(src + (long)(k0 + kk) * ldsrc + n0 + nn));
    float s = kscale ? kscale[k0 + kk] : 1.f;
    tile[(nn + 0) * 65 + kk] = v.x * s; tile[(nn + 1) * 65 + kk] = v.y * s; tile[(nn + 2) * 65 + kk] = v.z * s; tile[(nn + 3) * 65 + kk] = v.w * s;
  }
  __syncthreads();
  {
    int nn = tid >> 2, ks = (tid & 3) * 16;
    const float* t = tile + nn * 65 + ks;
    uint4 a, b;
    a.x = pack2(t[0], t[1]); a.y = pack2(t[2], t[3]); a.z = pack2(t[4], t[5]); a.w = pack2(t[6], t[7]);
    b.x = pack2(t[8], t[9]); b.y = pack2(t[10], t[11]); b.z = pack2(t[12], t[13]); b.w = pack2(t[14], t[15]);
    int n = n0 + nn, drow;
    if (mode == 0) drow = n;
    else { int which = n >= DFF ? 1 : 0, j = n - which * DFF; drow = (j >> 5) * 64 + which * 32 + (j & 31); }
    bf16_t* d = dst + (long)drow * ldd + k0 + ks;
    *(uint4*)d = a; *(uint4*)(d + 8) = b;
  }
}

DI void convert_layer(int l, char* smem) {
  PP p = get_params();
  const int nGU = 1408, nD = 704, nIN = 2192, nUQ = 96, nUKV = 128, nSQ = 256, nRG = 16;
  const int total = 2 * nGU + 2 * nD + nIN + nUQ + nUKV + 4 * nSQ + 2 * nRG;
  bf16_t* wb = p->wb;
  for (int t = blockIdx.x; t < total; t += gridDim.x) {
    int u = t;
    const float* src; int K, N; bf16_t* dst; int mode = 0; const float* ks = nullptr;
    if (u < nGU) { src = (const float*)p->in[3] + (long)l * 1024 * 5632; K = 1024; N = 5632; dst = wb + W_GU1; mode = 1; }
    else if ((u -= nGU) < nD) { src = (const float*)p->in[4] + (long)l * 2816 * 1024; K = 2816; N = 1024; dst = wb + W_D1; }
    else if ((u -= nD) < nIN) { src = (const float*)p->in[6] + (long)l * 1024 * 8768; K = 1024; N = 8768; dst = wb + W_IN; }
    else if ((u -= nIN) < nUQ) { src = (const float*)p->in[15] + (long)l * 256 * 1536; K = 256; N = 1536; dst = wb + W_UQ; ks = (const float*)p->in[14] + l * 256; }
    else if ((u -= nUQ) < nUKV) { src = (const float*)p->in[17] + (long)l * 256 * 2048; K = 256; N = 2048; dst = wb + W_UKV; ks = (const float*)p->in[16] + l * 256; }
    else if ((u -= nUKV) < nSQ) { src = (const float*)p->in[18] + (long)l * 1024 * 1024; K = 1024; N = 1024; dst = wb + W_BA; }
    else if ((u -= nSQ) < nSQ) { src = (const float*)p->in[19] + (long)l * 1024 * 1024; K = 1024; N = 1024; dst = wb + W_BB; }
    else if ((u -= nSQ) < nSQ) { src = (const float*)p->in[20] + (long)l * 1024 * 1024; K = 1024; N = 1024; dst = wb + W_BC; }
    else if ((u -= nSQ) < nSQ) { src = (const float*)p->in[21] + (long)l * 1024 * 1024; K = 1024; N = 1024; dst = wb + W_OUT; }
    else if ((u -= nSQ) < nGU) { src = (const float*)p->in[23] + (long)l * 1024 * 5632; K = 1024; N = 5632; dst = wb + W_GU2; mode = 1; }
    else if ((u -= nGU) < nD) { src = (const float*)p->in[24] + (long)l * 2816 * 1024; K = 2816; N = 1024; dst = wb + W_D2; }
    else if ((u -= nD) < nRG) { src = (const float*)p->in[9] + (long)l * 65536 + (long)u * 4096; K = 64; N = 64; dst = wb + W_RGA + (long)u * 4096; u = 0; }
    else { u -= nRG; src = (const float*)p->in[11] + (long)l * 65536 + (long)u * 4096; K = 64; N = 64; dst = wb + W_RGX + (long)u * 4096; u = 0; }
    int ntn = N >> 6;
    int kt = u / ntn, nt = u - kt * ntn;
    conv_tile(src, N, kt * 64, nt * 64, dst, K, mode, ks, smem);
  }
}

template <bool FINAL>
DI void norm_phase(const float* x, const float* g, bf16_t* outb, float* outf) {
  const int lane = otid() & 63;
  const int gw = blockIdx.x * 4 + (otid() >> 6), nw = gridDim.x * 4;
  float4 gg[4];
#pragma unroll
  for (int i = 0; i < 4; ++i) gg[i] = *(const float4*)(g + lane * 4 + 256 * i);
  for (int row = gw; row < T_TOK; row += nw) {
    const float* xr = x + (long)row * DM;
    float4 v[4]; float ss = 0.f;
#pragma unroll
    for (int i = 0; i < 4; ++i) {
      typedef float f4n_t __attribute__((ext_vector_type(4)));
      if (FINAL) { const f4n_t t = __builtin_nontemporal_load((const f4n_t*)(xr + lane * 4 + 256 * i)); v[i] = make_float4(t.x, t.y, t.z, t.w); }
      else v[i] = *(const float4*)(xr + lane * 4 + 256 * i);
      ss += v[i].x * v[i].x + v[i].y * v[i].y + v[i].z * v[i].z + v[i].w * v[i].w;
    }
#pragma unroll
    for (int o = 32; o >= 1; o >>= 1) ss += __shfl_xor(ss, o);
    const float ri = rsqrtf(ss * (1.f / 1024.f) + 1e-6f);
#pragma unroll
    for (int i = 0; i < 4; ++i) {
      float o[4] = {v[i].x * ri * gg[i].x, v[i].y * ri * gg[i].y, v[i].z * ri * gg[i].z, v[i].w * ri * gg[i].w};
      if (FINAL) { typedef float f4n_t __attribute__((ext_vector_type(4))); const f4n_t t = {o[0], o[1], o[2], o[3]};
                   __builtin_nontemporal_store(t, (f4n_t*)(outf + (long)row * DM + lane * 4 + 256 * i)); }
      else store4bf(outb + (long)row * DM + lane * 4 + 256 * i, o);
    }
  }
}

template <class Epi>
DI void gemm_phase(const GemmSpec& g, Epi& epi, char* smem) {
  const int ntn = (g.Nv + 127) >> 7, ntm = T_TOK >> 7;
  const int G = gridDim.x;
  const bool xo = (G & 7) == 0;
  const int band = xo ? ntm >> 3 : ntm, ustep = xo ? G >> 3 : G, u0 = xo ? (int)(blockIdx.x >> 3) : (int)blockIdx.x, mbase = xo ? (int)(blockIdx.x & 7) * band : 0;
  const int utot = band * ntn;
#if NAIVE_GEMM
  for (int u = u0; u < utot; u += ustep) {
    int nt = u / band, mt = mbase + (u - nt * band);
    f32x16 acc[2][2];
    gemm_main<2, 2>(g, mt * 128, nt * 128, acc, smem);
    gemm_epi(acc, mt * 128, nt * 128, g.Nv, epi, smem);
  }
#else
  constexpr int NI = 2;
  const int tid = otid(), lane = tid & 63, wave = tid >> 6;
  const int r = lane & 31, hh = lane >> 5, wm = wave >> 1, wn = wave & 1;
  bf16_t* sA = (bf16_t*)smem;
  bf16_t* sB = sA + 2 * 128 * LROW;
  const int srow = tid >> 3, skc = tid & 7;
  const long lda32 = (long)32 * g.lda, ldb32 = (long)32 * g.K;
  const int KT = g.K >> 6;
  bf16_t* wA = sA + srow * LROW + skc * 8;
  bf16_t* wB = sB + srow * LROW + skc * 8;
  uint4 a00, a01, a02, a03, b00, b01, b02, b03, a10, a11, a12, a13, b10, b11, b12, b13;
  const bf16_t* Ap = g.A;
  const bf16_t* Bp0 = g.Bt;
  int u = u0;
  if (u < utot) {
    const int nt = u / band, mt = mbase + (u - nt * band);
    Ap = g.A + (long)(mt * 128 + srow) * g.lda + skc * 8;
    Bp0 = g.Bt + (long)(nt * 128 + srow) * g.K + skc * 8;
    G_LOAD(0, 0)
    G_LOAD(1, 1)
  }
  for (; u < utot; u += ustep) {
    const int nt = u / band, mt = mbase + (u - nt * band), m0 = mt * 128, n0 = nt * 128;
    f32x16 acc[2][2];
#pragma unroll
    for (int a = 0; a < 2; ++a)
#pragma unroll
      for (int b = 0; b < 2; ++b)
#pragma unroll
        for (int i = 0; i < 16; ++i) acc[a][b][i] = 0.f;
    __syncthreads();
    G_STORE(0, 0)
    if (KT > 2) G_LOAD(0, 2)
    __syncthreads();
    for (int kt = 0; kt < KT; kt += 2) {
      const bool l3 = kt + 3 < KT, more = kt + 2 < KT, l4 = kt + 4 < KT;
      G_COMPUTE_ST(0, 1, 1, true, l3, kt + 3)
      __syncthreads();
      G_COMPUTE_ST(1, 0, 0, more, l4, kt + 4)
      __syncthreads();
    }
    const int un = u + ustep;
    if (un < utot) {
      const int nt2 = un / band, mt2 = mbase + (un - nt2 * band);
      Ap = g.A + (long)(mt2 * 128 + srow) * g.lda + skc * 8;
      Bp0 = g.Bt + (long)(nt2 * 128 + srow) * g.K + skc * 8;
      G_LOAD(0, 0)
      G_LOAD(1, 1)
    }
    gemm_epi(acc, m0, n0, g.Nv, epi, smem);
  }
#endif
}

DI void merge_phase(int l, char* smem) {
  PP p = get_params();
  const int G = gridDim.x;
  const bool xo = (G & 7) == 0;
  const int band = xo ? 16 : 128, ustep = xo ? G >> 3 : G, u0 = xo ? (int)(blockIdx.x >> 3) : (int)blockIdx.x, mbase = xo ? (int)(blockIdx.x & 7) * 16 : 0;
  for (int u = u0; u < band * 8; u += ustep) {
    const int nt = u / band, mt = mbase + (u - nt * band), m0 = mt * 128, n0 = nt * 128;
    const int lane = otid() & 63, wave = otid() >> 6;
    const int r = lane & 31, hh = lane >> 5, wm = wave >> 1, wn = wave & 1;
    f32x16 tot[2][2];
#pragma unroll
    for (int a = 0; a < 2; ++a)
#pragma unroll
      for (int b = 0; b < 2; ++b)
#pragma unroll
        for (int i = 0; i < 16; ++i) tot[a][b][i] = 0.f;
#pragma unroll 1
    for (int br = 0; br < 3; ++br) {
      GemmSpec g;
      if (br == 0) { g.A = p->Y + C_RGG; g.lda = NIN; g.Bt = p->wb + W_BA; g.W = (const float*)p->in[18] + (long)l * 1048576; }
      else if (br == 1) { g.A = p->Y + C_SBQ; g.lda = NIN; g.Bt = p->wb + W_BB; g.W = (const float*)p->in[19] + (long)l * 1048576; }
      else { g.A = p->hb; g.lda = 1024; g.Bt = p->wb + W_BC; g.W = (const float*)p->in[20] + (long)l * 1048576; }
      g.K = 1024; g.Nv = 1024; g.ldw = 1024; g.mapmode = 0; g.kscale = nullptr;
      f32x16 acc[2][2];
      gemm_main<2, 2, 2>(g, m0, n0, acc, smem);
      const bf16_t* gbase = p->Y + C_GATE + br * 1024;
#pragma unroll
      for (int mi = 0; mi < 2; ++mi)
#pragma unroll
        for (int ni = 0; ni < 2; ++ni)
#pragma unroll
          for (int gq = 0; gq < 4; ++gq) {
            int m = m0 + wm * 64 + mi * 32 + r, n = n0 + wn * 64 + ni * 32 + 8 * gq + 4 * hh;
            uint2 gl = *(const uint2*)(gbase + (long)m * NIN + n);
            tot[mi][ni][4 * gq + 0] += sigmoidf_(bflo(gl.x)) * acc[mi][ni][4 * gq + 0];
            tot[mi][ni][4 * gq + 1] += sigmoidf_(bfhi(gl.x)) * acc[mi][ni][4 * gq + 1];
            tot[mi][ni][4 * gq + 2] += sigmoidf_(bflo(gl.y)) * acc[mi][ni][4 * gq + 2];
            tot[mi][ni][4 * gq + 3] += sigmoidf_(bfhi(gl.y)) * acc[mi][ni][4 * gq + 3];
          }
    }
    struct EpiPlain {
      bf16_t* out;
      DI EpiDest dest(int mw, int nw) const { return EpiDest{0, out + (long)mw * 1024 + nw, 1024}; }
      DI void compute(int, int, const float (&v0)[4], const float (&v1)[4], float (&o0)[4], float (&o1)[4]) const {
#pragma unroll
        for (int j = 0; j < 4; ++j) { o0[j] = v0[j]; o1[j] = v1[j]; }
      }
    } ep{p->qb};
    gemm_epi(tot, m0, n0, 1024, ep, smem);
  }
}

DI void rg_item(int l, int item, int stage, char* smem, int dmy) {
  PP p = get_params();
  const int b = item >> 10, c = (item >> 4) & 63, nb = item & 15, cb = nb * 64, t0 = c * 64;
  const int tid = otid(), lane = tid & 63, wave = tid >> 6, r = lane & 31, hh = lane >> 5;
  float* xs = (float*)smem;
  float* aa = xs;
  float* uf = xs + 67 * 64;
  bf16_t* ub = (bf16_t*)(uf + 64 * 64);
  bf16_t* wa = ub + 64 * 72;
  bf16_t* wx = wa + 64 * 72;
  float* cst = (float*)(wx + 64 * 72);
  bf16_t* Yb = p->Y + (long)b * SEQ * NIN;
  float* sumA = p->rgsum + ((long)b * 64) * 2048 + cb;
  __syncthreads();
  float hstate = 0.f;
  if (stage == 1 && wave == 0) {
#pragma unroll 8
    for (int cc = 0; cc < c; ++cc) hstate = sumA[(long)cc * 2048 + lane] * hstate + sumA[(long)cc * 2048 + 1024 + lane];
  }
  if (tid < 64) {
    int ch = cb + tid;
    cst[0 * 64 + tid] = ((const float*)p->in[10])[l * 1024 + ch];
    cst[1 * 64 + tid] = ((const float*)p->in[12])[l * 1024 + ch];
    float lam = ((const float*)p->in[13])[l * 1024 + ch];
    cst[2 * 64 + tid] = log1pf(expf(-lam));
    cst[3 * 64 + tid] = ((const float*)p->in[8])[l * 1024 + ch];
#pragma unroll
    for (int tap = 0; tap < 4; ++tap) cst[(4 + tap) * 64 + tid] = ((const float*)p->in[7])[(l * 4 + tap) * 1024 + ch];
  }
#pragma unroll
  for (int i = 0; i < 2; ++i) {
    int e = tid + 256 * i, row = e >> 3, kc = e & 7;
    *(uint4*)(wa + row * 72 + kc * 8) = *(const uint4*)(p->wb + W_RGA + nb * 4096 + row * 64 + kc * 8);
    *(uint4*)(wx + row * 72 + kc * 8) = *(const uint4*)(p->wb + W_RGX + nb * 4096 + row * 64 + kc * 8);
  }
#pragma unroll
  for (int i = 0; i < 3; ++i) {
    int e = tid + 256 * i;
    if (e < 67 * 8) {
      int rr = e >> 3, kc = e & 7, t = t0 - 3 + rr;
      uint4 v = make_uint4(0u, 0u, 0u, 0u);
      if (t >= 0) v = *(const uint4*)(Yb + (long)t * NIN + C_RGX + cb + kc * 8);
      float* d = xs + rr * 64 + kc * 8;
      d[0] = bflo(v.x); d[1] = bfhi(v.x); d[2] = bflo(v.y); d[3] = bfhi(v.y); d[4] = bflo(v.z); d[5] = bfhi(v.z); d[6] = bflo(v.w); d[7] = bfhi(v.w);
    }
  }
  __syncthreads();
  {
    const int ch = tid & 63, tq = tid >> 6;
    const float cbias = cst[3 * 64 + ch], w0 = cst[4 * 64 + ch], w1 = cst[5 * 64 + ch], w2 = cst[6 * 64 + ch], w3 = cst[7 * 64 + ch];
#pragma unroll 4
    for (int tt = 0; tt < 16; ++tt) {
      int t = tq * 16 + tt;
      float u = cbias + w0 * xs[(t + 0) * 64 + ch] + w1 * xs[(t + 1) * 64 + ch] + w2 * xs[(t + 2) * 64 + ch] + w3 * xs[(t + 3) * 64 + ch];
      uf[t * 64 + ch] = u;
      ub[t * 72 + ch] = f2bf(u);
    }
  }
  __syncthreads();
  {
    const int tb = 32 * (wave >> 1), cb2 = 32 * (wave & 1);
    f32x16 accA, accX;
#pragma unroll
    for (int i = 0; i < 16; ++i) { accA[i] = 0.f; accX[i] = 0.f; }
#if !NAIVE_RG
#pragma unroll
    for (int kk = 0; kk < 4; ++kk) {
      bf16x8 uu = *(const bf16x8*)(ub + (tb + r) * 72 + kk * 16 + hh * 8);
      bf16x8 fa = *(const bf16x8*)(wa + (cb2 + r) * 72 + kk * 16 + hh * 8);
      bf16x8 fx = *(const bf16x8*)(wx + (cb2 + r) * 72 + kk * 16 + hh * 8);
      accA = MFMA(fa, uu, accA);
      accX = MFMA(fx, uu, accX);
    }
#else
    {
      const float* Wa = (const float*)p->in[9] + (long)l * 65536 + nb * 4096;
      const float* Wx = (const float*)p->in[11] + (long)l * 65536 + nb * 4096;
      for (int j = 0; j < 64; ++j) {
        float u = uf[(tb + r) * 64 + j];
#pragma unroll
        for (int i = 0; i < 16; ++i) { int ko = cb2 + crow(i, hh); accA[i] += u * Wa[j * 64 + ko]; accX[i] += u * Wx[j * 64 + ko]; }
      }
    }
#endif
#pragma unroll
    for (int i = 0; i < 16; ++i) {
      int ch = cb2 + crow(i, hh), t = tb + r;
      float rg = sigmoidf_(accA[i] + cst[0 * 64 + ch]);
      float ig = sigmoidf_(accX[i] + cst[1 * 64 + ch]);
      float la = -8.f * cst[2 * 64 + ch] * rg;
      float a = __expf(la);
      float bc = sqrtf(fmaxf(1.f - a * a, 0.f)) * ig * uf[t * 64 + ch];
      aa[t * 64 + ch] = a;
      uf[t * 64 + ch] = bc;
    }
  }
  __syncthreads();
  if (stage == 0) {
    if (wave == 0) {
      float ap = 1.f, h = 0.f;
#pragma unroll 8
      for (int t = 0; t < 64; ++t) { float a = aa[t * 64 + lane]; h = a * h + uf[t * 64 + lane]; ap *= a; }
      sumA[(long)c * 2048 + lane] = ap;
      sumA[(long)c * 2048 + 1024 + lane] = h;
    }
    return;
  }
  if (wave == 0) {
#pragma unroll 8
    for (int t = 0; t < 64; ++t) { hstate = aa[t * 64 + lane] * hstate + uf[t * 64 + lane]; uf[t * 64 + lane] = hstate; }
  }
  __syncthreads();
#pragma unroll
  for (int i = 0; i < 2; ++i) {
    int e = tid + 256 * i, t = e >> 3, kc = e & 7;
    bf16_t* gp = Yb + (long)(t0 + t) * NIN + C_RGG + cb + kc * 8;
    uint4 g = *(const uint4*)gp;
    const float* hp = uf + t * 64 + kc * 8;
    uint4 o;
    o.x = pack2(hp[0] * gelu_tanh(bflo(g.x)), hp[1] * gelu_tanh(bfhi(g.x)));
    o.y = pack2(hp[2] * gelu_tanh(bflo(g.y)), hp[3] * gelu_tanh(bfhi(g.y)));
    o.z = pack2(hp[4] * gelu_tanh(bflo(g.z)), hp[5] * gelu_tanh(bfhi(g.z)));
    o.w = pack2(hp[6] * gelu_tanh(bflo(g.w)), hp[7] * gelu_tanh(bfhi(g.w)));
    bf16_t* op = dmy ? p->vtb + ((long)b * SEQ + t0 + t) * 1024 + cb + kc * 8 : gp;
    *(uint4*)op = o;
  }
}

constexpr float SB_SCALE = 0.08838834764831845f;
constexpr float MLA_SCALE = 0.07216878364870323f;

DI void sb_item(int item, char* smem, int dmy) {
  PP p = get_params();
  const int qblk = 31 - (item >> 5), bh = item & 31, b = bh >> 3, hd = bh & 7;
  const int tid = otid(), lane = tid & 63, wave = tid >> 6, r = lane & 31, hh = lane >> 5;
  bf16_t* Yb = p->Y + (long)b * SEQ * NIN;
  const int qs = qblk * 128 + wave * 32;
#if !NAIVE_ATTN
  bf16_t* sK = (bf16_t*)smem;
  bf16_t* sV = sK + 64 * 136;
  bf16x8 qf[8];
#pragma unroll
  for (int kk = 0; kk < 8; ++kk) qf[kk] = *(const bf16x8*)(Yb + (long)(qs + r) * NIN + C_SBQ + hd * 128 + kk * 16 + hh * 8);
  f32x16 o[4];
#pragma unroll
  for (int dt = 0; dt < 4; ++dt)
#pragma unroll
    for (int i = 0; i < 16; ++i) o[dt][i] = 0.f;
  float cy = 0.f;
  const bf16_t* Kg = Yb + C_SBK + hd * 128;
  const bf16_t* Vg = p->vtb + (long)(b * 8 + hd) * 128 * SEQ;
  const int ntiles = qblk * 2 + 2;
  const int krow_ = tid >> 4, kkc = tid & 15, vrow = tid >> 3, vkc = tid & 7;
  uint4 rk0, rk1, rk2, rk3, rv0, rv1, rv2, rv3;
  const bf16_t* kgp = Kg + (long)krow_ * NIN + kkc * 8;
  const bf16_t* vgp = Vg + (long)vrow * SEQ + vkc * 8;
#define SB_LOAD(KT) { const bf16_t* kq = kgp + (long)((KT) * 64) * NIN; const bf16_t* vq = vgp + (KT) * 64; \
    rk0 = *(const uint4*)(kq); rk1 = *(const uint4*)(kq + 16L * NIN); rk2 = *(const uint4*)(kq + 32L * NIN); rk3 = *(const uint4*)(kq + 48L * NIN); \
    rv0 = *(const uint4*)(vq); rv1 = *(const uint4*)(vq + 32L * SEQ); rv2 = *(const uint4*)(vq + 64L * SEQ); rv3 = *(const uint4*)(vq + 96L * SEQ); }
#define ST_V(ROW, RV) { bf16_t* dq = sV + (ROW) * 72 + (vkc >> 1) * 16 + (vkc & 1) * 4; *(uint2*)dq = make_uint2(RV.x, RV.y); *(uint2*)(dq + 8) = make_uint2(RV.z, RV.w); }
  SB_LOAD(ntiles - 1)
  int wdone = 0;
  volatile int* dflag = (volatile int*)(smem + SMEM_ITEM + 16);
  __syncthreads();
  if (lane == 0) dflag[wave] = 0;
  for (int kt = ntiles - 1; kt >= 0; --kt) {
    __syncthreads();
    if ((dflag[0] & dflag[1] & dflag[2] & dflag[3]) != 0) break;
    *(uint4*)(sK + (krow_) * 136 + kkc * 8) = rk0; *(uint4*)(sK + (krow_ + 16) * 136 + kkc * 8) = rk1;
    *(uint4*)(sK + (krow_ + 32) * 136 + kkc * 8) = rk2; *(uint4*)(sK + (krow_ + 48) * 136 + kkc * 8) = rk3;
    ST_V(vrow, rv0) ST_V(vrow + 32, rv1) ST_V(vrow + 64, rv2) ST_V(vrow + 96, rv3)
    __syncthreads();
    if (kt > 0) SB_LOAD(kt - 1)
#pragma unroll 1
    for (int sub = 1; sub >= 0; --sub) {
      const int ks = kt * 64 + sub * 32;
      if (wdone || ks >= qs + 31) continue;
      f32x16 S;
#pragma unroll
      for (int i = 0; i < 16; ++i) S[i] = 0.f;
#pragma unroll
      for (int kk = 0; kk < 8; ++kk) {
        bf16x8 kf = *(const bf16x8*)(sK + (sub * 32 + r) * 136 + kk * 16 + hh * 8);
        S = MFMA(kf, qf[kk], S);
      }
      const bool diag = (ks + 31 >= qs);
      const int tq = qs + r;
      float lk[16], ls[16];
#pragma unroll
      for (int i = 0; i < 16; ++i) {
        float z = S[i] * SB_SCALE;
        float e = __expf(-fabsf(z));
        float l1p = __logf(1.f + e);
        ls[i] = fminf(z, 0.f) - l1p;
        lk[i] = ls[i] - z;
        if (diag) { bool valid = (ks + crow(i, hh)) < tq; if (!valid) { lk[i] = 0.f; ls[i] = -1e30f; } }
      }
      float own[4], oth[4];
#pragma unroll
      for (int gq = 0; gq < 4; ++gq) own[gq] = (lk[4 * gq] + lk[4 * gq + 1]) + (lk[4 * gq + 2] + lk[4 * gq + 3]);
#pragma unroll
      for (int gq = 0; gq < 4; ++gq) oth[gq] = __shfl_xor(own[gq], 32);
      float sg = cy;
      float w[16];
#pragma unroll
      for (int gq = 3; gq >= 0; --gq) {
        float run = sg + (hh == 0 ? oth[gq] : 0.f);
#pragma unroll
        for (int j = 3; j >= 0; --j) { w[4 * gq + j] = __expf(ls[4 * gq + j] + run); run += lk[4 * gq + j]; }
        sg += own[gq] + oth[gq];
      }
      cy = sg;
      wdone = (__builtin_amdgcn_ballot_w64(cy >= -110.f) == 0ull);
      if (wdone && lane == 0) dflag[wave] = 1;
#pragma unroll
      for (int s = 0; s < 2; ++s) {
        uint4 pk;
        pk.x = pack2(w[8 * s + 0], w[8 * s + 1]); pk.y = pack2(w[8 * s + 2], w[8 * s + 3]);
        pk.z = pack2(w[8 * s + 4], w[8 * s + 5]); pk.w = pack2(w[8 * s + 6], w[8 * s + 7]);
        bf16x8 pf = __builtin_bit_cast(bf16x8, pk);
#pragma unroll
        for (int dt = 0; dt < 4; ++dt) {
          const uint4 vv = *(const uint4*)(sV + (dt * 32 + r) * 72 + sub * 32 + 16 * s + 8 * hh);
          o[dt] = MFMA(__builtin_bit_cast(bf16x8, vv), pf, o[dt]);
        }
      }
    }
  }
#pragma unroll
  for (int dt = 0; dt < 4; ++dt)
#pragma unroll
    for (int gq = 0; gq < 4; ++gq) {
      float ov[4] = {o[dt][4 * gq], o[dt][4 * gq + 1], o[dt][4 * gq + 2], o[dt][4 * gq + 3]};
      bf16_t* ob = dmy ? p->hb + (long)b * SEQ * 1024 + hd * 128 : Yb + C_SBQ + hd * 128;
      const long os = dmy ? 1024 : NIN;
      store4bf(ob + (long)(qs + r) * os + dt * 32 + 8 * gq + 4 * hh, ov);
    }
#else
  const bf16_t* Vg = p->vtb + (long)(b * 8 + hd) * 128 * SEQ;
  for (int ri = 0; ri < 32; ++ri) {
    const int t = qs + ri;
    unsigned qq = *(const unsigned*)(Yb + (long)t * NIN + C_SBQ + hd * 128 + 2 * lane);
    const float q0 = bflo(qq), q1 = bfhi(qq);
    float o0 = 0.f, o1 = 0.f, cyv = 0.f;
    for (int s = t - 1; s >= 0; --s) {
      unsigned kk2 = *(const unsigned*)(Yb + (long)s * NIN + C_SBK + hd * 128 + 2 * lane);
      float part = q0 * bflo(kk2) + q1 * bfhi(kk2);
#pragma unroll
      for (int of = 32; of >= 1; of >>= 1) part += __shfl_xor(part, of);
      float z = part * SB_SCALE;
      float lsg = fminf(z, 0.f) - log1pf(expf(-fabsf(z)));
      float wgt = expf(lsg + cyv);
      cyv += lsg - z;
      float v0 = bf2f(Vg[(long)(2 * lane) * SEQ + s]), v1 = bf2f(Vg[(long)(2 * lane + 1) * SEQ + s]);
      o0 += wgt * v0; o1 += wgt * v1;
    }
    *(unsigned*)(Yb + (long)t * NIN + C_SBQ + hd * 128 + 2 * lane) = pack2(o0, o1);
  }
#endif
}

DI void mla_item(int item, char* smem) {
  PP p = get_params();
  const int qblk = 31 - (item >> 5), bh = item & 31, b = bh >> 3, hd = bh & 7;
  const int tid = otid(), lane = tid & 63, wave = tid >> 6, r = lane & 31, hh = lane >> 5;
  const int qs = qblk * 128 + wave * 32;
  const bf16_t* Qg = p->qb + (long)b * SEQ * 1536 + hd * 192;
  const bf16_t* Kn = p->kb + (long)b * SEQ * 1024 + hd * 128;
  const bf16_t* Kr = p->Y + (long)b * SEQ * NIN + C_KR;
  const bf16_t* Vg = p->vtc + (long)(b * 8 + hd) * 128 * SEQ;
  bf16_t* Og = p->hb + (long)b * SEQ * 1024 + hd * 128;
#if !NAIVE_ATTN
  bf16_t* sK = (bf16_t*)smem;
  bf16_t* sR = sK + 64 * 136;
  bf16_t* sV = sR + 64 * 72;
  bf16x8 qf[12];
#pragma unroll
  for (int kk = 0; kk < 12; ++kk) qf[kk] = *(const bf16x8*)(Qg + (long)(qs + r) * 1536 + kk * 16 + hh * 8);
  f32x16 o[4];
#pragma unroll
  for (int dt = 0; dt < 4; ++dt)
#pragma unroll
    for (int i = 0; i < 16; ++i) o[dt][i] = 0.f;
  float mrun = -1e30f, lrun = 0.f;
  const int nt_blk = qblk * 2 + 2, nt_w = (qs >> 6) + 1;
  const int krow_ = tid >> 4, kkc = tid & 15, vrow = tid >> 3, vkc = tid & 7;
  uint4 rk0, rk1, rk2, rk3, rv0, rv1, rv2, rv3, rr0, rr1;
  const bf16_t* kgp = Kn + (long)krow_ * 1024 + kkc * 8;
  const bf16_t* vgp = Vg + (long)vrow * SEQ + vkc * 8;
  const bf16_t* rgp = Kr + (long)vrow * NIN + vkc * 8;
#define MLA_LOAD(KT) { const bf16_t* kq = kgp + (long)((KT) * 64) * 1024; const bf16_t* vq = vgp + (KT) * 64; const bf16_t* rq = rgp + (long)((KT) * 64) * NIN; \
    rk0 = *(const uint4*)(kq); rk1 = *(const uint4*)(kq + 16L * 1024); rk2 = *(const uint4*)(kq + 32L * 1024); rk3 = *(const uint4*)(kq + 48L * 1024); \
    rv0 = *(const uint4*)(vq); rv1 = *(const uint4*)(vq + 32L * SEQ); rv2 = *(const uint4*)(vq + 64L * SEQ); rv3 = *(const uint4*)(vq + 96L * SEQ); \
    rr0 = *(const uint4*)(rq); rr1 = *(const uint4*)(rq + 32L * NIN); }
  MLA_LOAD(0)
  for (int kt = 0; kt < nt_blk; ++kt) {
    __syncthreads();
    *(uint4*)(sK + (krow_) * 136 + kkc * 8) = rk0; *(uint4*)(sK + (krow_ + 16) * 136 + kkc * 8) = rk1;
    *(uint4*)(sK + (krow_ + 32) * 136 + kkc * 8) = rk2; *(uint4*)(sK + (krow_ + 48) * 136 + kkc * 8) = rk3;
    ST_V(vrow, rv0) ST_V(vrow + 32, rv1) ST_V(vrow + 64, rv2) ST_V(vrow + 96, rv3)
    *(uint4*)(sR + (vrow) * 72 + vkc * 8) = rr0; *(uint4*)(sR + (vrow + 32) * 72 + vkc * 8) = rr1;
    __syncthreads();
    if (kt + 1 < nt_blk) MLA_LOAD(kt + 1)
    if (kt < nt_w) {
#define MLA_QK(SUB, SV) { \
        _Pragma("unroll") for (int i = 0; i < 16; ++i) SV[i] = 0.f; \
        _Pragma("unroll") for (int kk = 0; kk < 8; ++kk) { \
          bf16x8 kf = *(const bf16x8*)(sK + ((SUB) * 32 + r) * 136 + kk * 16 + hh * 8); \
          SV = MFMA(kf, qf[kk], SV); } \
        _Pragma("unroll") for (int kk = 0; kk < 4; ++kk) { \
          bf16x8 kf = *(const bf16x8*)(sR + ((SUB) * 32 + r) * 72 + kk * 16 + hh * 8); \
          SV = MFMA(kf, qf[8 + kk], SV); } }
#define MLA_SM_PV(SUB, SV) { \
        uint4 vfr[2][4]; \
        _Pragma("unroll") for (int s2 = 0; s2 < 2; ++s2) \
          _Pragma("unroll") for (int dt = 0; dt < 4; ++dt) { \
            vfr[s2][dt] = *(const uint4*)(sV + (dt * 32 + r) * 72 + (SUB) * 32 + 16 * s2 + 8 * hh); } \
        float mx = SV[0]; \
        _Pragma("unroll") for (int i = 1; i < 16; ++i) mx = fmaxf(mx, SV[i]); \
        mx = fmaxf(mx, __shfl_xor(mx, 32)); \
        const float mnew = fmaxf(mrun, mx * MLA_SCALE); \
        if (__builtin_amdgcn_ballot_w64(mnew > mrun + 8.f) != 0ull) {     \
          const float alpha = __expf(mrun - mnew); \
          lrun *= alpha; \
          _Pragma("unroll") for (int dt = 0; dt < 4; ++dt) \
            _Pragma("unroll") for (int i = 0; i < 16; ++i) o[dt][i] *= alpha; \
          mrun = mnew; \
        } \
        float psum = 0.f; \
        _Pragma("unroll") for (int i = 0; i < 16; ++i) { float pv = __expf(SV[i] * MLA_SCALE - mrun); SV[i] = pv; psum += pv; } \
        lrun += psum; \
        _Pragma("unroll") for (int s2 = 0; s2 < 2; ++s2) { \
          uint4 pk; \
          pk.x = pack2(SV[8 * s2 + 0], SV[8 * s2 + 1]); pk.y = pack2(SV[8 * s2 + 2], SV[8 * s2 + 3]); \
          pk.z = pack2(SV[8 * s2 + 4], SV[8 * s2 + 5]); pk.w = pack2(SV[8 * s2 + 6], SV[8 * s2 + 7]); \
          bf16x8 pf = __builtin_bit_cast(bf16x8, pk); \
          _Pragma("unroll") for (int dt = 0; dt < 4; ++dt) o[dt] = MFMA(__builtin_bit_cast(bf16x8, vfr[s2][dt]), pf, o[dt]); \
          } }
      f32x16 S0, S1;
      MLA_QK(0, S0)
      MLA_QK(1, S1)
      __builtin_amdgcn_sched_barrier(0);
      MLA_SM_PV(0, S0)
      __builtin_amdgcn_sched_barrier(0);
      MLA_SM_PV(1, S1)
#undef MLA_QK
#undef MLA_SM_PV
    }
  }
  const float ltot = lrun + __shfl_xor(lrun, 32);
  const float linv = 1.f / ltot;
#pragma unroll
  for (int dt = 0; dt < 4; ++dt)
#pragma unroll
    for (int gq = 0; gq < 4; ++gq) {
      float ov[4] = {o[dt][4 * gq] * linv, o[dt][4 * gq + 1] * linv, o[dt][4 * gq + 2] * linv, o[dt][4 * gq + 3] * linv};
      store4bf(Og + (long)(qs + r) * 1024 + dt * 32 + 8 * gq + 4 * hh, ov);
    }
#else
  for (int ri = 0; ri < 32; ++ri) {
    const int t = qs + ri;
    unsigned qq = *(const unsigned*)(Qg + (long)t * 1536 + 2 * lane);
    const float q0 = bflo(qq), q1 = bfhi(qq), q2 = bf2f(Qg[(long)t * 1536 + 128 + lane]);
    float o0 = 0.f, o1 = 0.f, mr = -1e30f, lr = 0.f;
    const int kend = ((t >> 6) + 1) * 64;
    for (int s = 0; s < kend; ++s) {
      unsigned kk2 = *(const unsigned*)(Kn + (long)s * 1024 + 2 * lane);
      float part = q0 * bflo(kk2) + q1 * bfhi(kk2) + q2 * bf2f(Kr[(long)s * NIN + lane]);
#pragma unroll
      for (int of = 32; of >= 1; of >>= 1) part += __shfl_xor(part, of);
      float sc = part * MLA_SCALE;
      float mn = fmaxf(mr, sc), al = expf(mr - mn), pv = expf(sc - mn);
      mr = mn; lr = lr * al + pv;
      float v0 = bf2f(Vg[(long)(2 * lane) * SEQ + s]), v1 = bf2f(Vg[(long)(2 * lane + 1) * SEQ + s]);
      o0 = o0 * al + pv * v0; o1 = o1 * al + pv * v1;
    }
    *(unsigned*)(Og + (long)t * 1024 + 2 * lane) = pack2(o0 / lr, o1 / lr);
  }
#endif
}

DI void mla_rinv(const bf16_t* A, int m0, float* rinv) {
  const int tid = otid(), row = tid >> 1, half = tid & 1;
  const bf16_t* ap = A + (long)(m0 + row) * NIN + half * 128;
  float ss = 0.f;
#pragma unroll 4
  for (int i = 0; i < 16; ++i) {
    uint4 v = *(const uint4*)(ap + i * 8);
    float a0 = bflo(v.x), a1 = bfhi(v.x), a2 = bflo(v.y), a3 = bfhi(v.y), a4 = bflo(v.z), a5 = bfhi(v.z), a6 = bflo(v.w), a7 = bfhi(v.w);
    ss += a0 * a0 + a1 * a1 + a2 * a2 + a3 * a3 + a4 * a4 + a5 * a5 + a6 * a6 + a7 * a7;
  }
  ss += __shfl_xor(ss, 1);
  __syncthreads();
  if (half == 0) rinv[row] = rsqrtf(ss * (1.f / 256.f) + 1e-6f);
  __syncthreads();
}

DI void mla_up_item(int l, int idx, bool isq, char* smem) {
  PP p = get_params();
  float* rinv = (float*)(smem + SMEM_RINV);
  GemmSpec g;
  int mt, nt;
  if (isq) { mt = idx / 12; nt = idx - mt * 12; g.A = p->Y + C_CQ; g.Bt = p->wb + W_UQ; g.Nv = 1536; g.W = (const float*)p->in[15] + (long)l * 256 * 1536; g.ldw = 1536; g.kscale = (const float*)p->in[14] + l * 256; }
  else { mt = idx >> 4; nt = idx & 15; g.A = p->Y + C_CKV; g.Bt = p->wb + W_UKV; g.Nv = 2048; g.W = (const float*)p->in[17] + (long)l * 256 * 2048; g.ldw = 2048; g.kscale = (const float*)p->in[16] + l * 256; }
  g.lda = NIN; g.K = 256; g.mapmode = 0;
  const int m0 = mt * 128, n0 = nt * 128;
  mla_rinv(g.A, m0, rinv);
  f32x16 acc[2][2];
  gemm_main<2, 2>(g, m0, n0, acc, smem);
  if (isq) { EpiQ e{p->qb, rinv, m0, p->cosb, p->sinb}; gemm_epi(acc, m0, n0, g.Nv, e, smem); }
  else { EpiKV e{p->kb, p->vtc, rinv, m0}; gemm_epi(acc, m0, n0, g.Nv, e, smem); }
}

DI int next_item(int* ctr, char* smem) {
  int* sh = (int*)(smem + SMEM_ITEM);
  __syncthreads();
  if (otid() == 0) *sh = atomicAdd(ctr, 1);
  __syncthreads();
  return *sh;
}

DI void grid_barrier(unsigned* bar, unsigned k) {
  asm volatile("s_waitcnt vmcnt(0)" ::: "memory");
  __syncthreads();
  if (otid() == 0) {
    __builtin_amdgcn_fence(__ATOMIC_RELEASE, "agent");
    asm volatile("s_waitcnt vmcnt(0)" ::: "memory");
    const unsigned G = gridDim.x, grp = blockIdx.x & 7u;
    const unsigned gsz = (G + 7u - grp) >> 3;
    const unsigned ngrp = G < 8u ? G : 8u;
    unsigned old = __hip_atomic_fetch_add(bar + 32 * (1 + grp), 1u, __ATOMIC_RELAXED, __HIP_MEMORY_SCOPE_AGENT);
    if (old + 1u == (k + 1u) * gsz) __hip_atomic_fetch_add(bar, 1u, __ATOMIC_RELAXED, __HIP_MEMORY_SCOPE_AGENT);
    while (__hip_atomic_load(bar, __ATOMIC_RELAXED, __HIP_MEMORY_SCOPE_AGENT) < (k + 1u) * ngrp) __builtin_amdgcn_s_sleep(4);
    __builtin_amdgcn_fence(__ATOMIC_ACQUIRE, "agent");
    asm volatile("s_waitcnt vmcnt(0)" ::: "memory");
  }
  __syncthreads();
}

DI void init_phase() {
  PP p = get_params();
  {
    if (!EN(15)) return;
    const float4* xin = (const float4*)p->in[0];
    float4* xo = (float4*)p->xres;
    const long n4 = (long)T_TOK * DM / 4;
    typedef float f4v_t __attribute__((ext_vector_type(4)));
    for (long i = (long)blockIdx.x * 256 + otid(); i < n4; i += (long)gridDim.x * 256) { const f4v_t v = __builtin_nontemporal_load((const f4v_t*)xin + i); xo[i] = make_float4(v.x, v.y, v.z, v.w); }
    const int* pos = (const int*)p->in[1];
    for (int i = blockIdx.x * 256 + otid(); i < T_TOK * 32; i += gridDim.x * 256) {
      int tok = i >> 5, f = i & 31;
      float inv = (float)exp(-(double)(2 * f) / 64.0 * 9.210340371976184);
      float ang = (float)pos[tok] * inv;
      p->cosb[i] = cosf(ang); p->sinb[i] = sinf(ang);
    }
    return;
  }
}

DI void run_phase(int ph, char* smem) {
  PP p = get_params();
  if (ph == NPH - 1) { if (EN(15)) norm_phase<true>(p->xres, (const float*)p->in[25], nullptr, p->xres); return; }
  const int l = (ph - 1) / 12, j = (ph - 1) % 12;
  switch (j) {
    case 0: for (int rep = 0; rep < REP_NORM; ++rep) { if (EN(0)) convert_layer(l, smem); if (EN(15)) norm_phase<false>(l == 0 ? (const float*)p->in[0] : (const float*)p->xres, (const float*)p->in[2] + l * DM, p->hb, nullptr); } break;
    case 1: case 10: if (EN(1)) {
      GemmSpec g; g.A = p->hb; g.lda = 1024; g.Bt = p->wb + (j == 1 ? W_GU1 : W_GU2); g.K = 1024; g.Nv = 5632;
      g.W = (const float*)p->in[j == 1 ? 3 : 23] + (long)l * 1024 * 5632; g.ldw = 5632; g.mapmode = 1; g.kscale = nullptr;
      EpiSwiglu e{p->Y};
      for (int rep = 0; rep < REP_FFN; ++rep) gemm_phase(g, e, smem);
    } break;
    case 2: case 11: if (EN(2)) {
      GemmSpec g; g.A = p->Y; g.lda = DFF; g.Bt = p->wb + (j == 2 ? W_D1 : W_D2); g.K = DFF; g.Nv = 1024;
      g.W = (const float*)p->in[j == 2 ? 4 : 24] + (long)l * 2816 * 1024; g.ldw = 1024; g.mapmode = 0; g.kscale = nullptr;
      for (int rep = 0; rep < REP_FFN; ++rep) { EpiResid e{p->xres, rep == REP_FFN - 1 ? 0.5f : 0.f}; gemm_phase(g, e, smem); }
    } break;
    case 3: for (int rep = 0; rep < REP_NORM; ++rep) if (EN(15)) norm_phase<false>(p->xres, (const float*)p->in[5] + l * DM, p->hb, nullptr); break;
    case 4: if (EN(4)) {
      GemmSpec g; g.A = p->hb; g.lda = 1024; g.Bt = p->wb + W_IN; g.K = 1024; g.Nv = NIN;
      g.W = (const float*)p->in[6] + (long)l * 1024 * NIN; g.ldw = NIN; g.mapmode = 0; g.kscale = nullptr;
      EpiWin e{p->Y, p->vtb, p->cosb, p->sinb};
      for (int rep = 0; rep < REP_WIN; ++rep) gemm_phase(g, e, smem);
    } break;
    case 5: {
      const int G = gridDim.x, b0 = blockIdx.x;
      for (int it = b0; it < 1024; it += G) { if (EN(13)) for (int rep = 0; rep < REP_SB; ++rep) sb_item(it, smem, rep < REP_SB - 1); }
      for (int it = b0; it < 1536; it += G) { if (EN(14)) for (int rep = 0; rep < REP_UP; ++rep) mla_up_item(l, it, true, smem); }
      for (int it = b0; it < 2048; it += G) { if (EN(14)) for (int rep = 0; rep < REP_UP; ++rep) mla_up_item(l, it, false, smem); }
      for (int it = b0; it < 4096; it += G) { if (EN(12)) for (int rep = 0; rep < REP_RG; ++rep) rg_item(l, it, 0, smem, 0); }
    } break;
    case 6: {
      const int G = gridDim.x, b0 = blockIdx.x;
      for (int it = b0; it < 512; it += G) {
        if (EN(6)) for (int rep = 0; rep < REP_MLA; ++rep) { mla_item(it, smem); mla_item(1023 - it, smem); }
      }
      for (int it = b0; it < 4096; it += G) { if (EN(12)) for (int rep = 0; rep < REP_RG; ++rep) rg_item(l, it, 1, smem, rep < REP_RG - 1); }
    } break;
    case 7: if (EN(7)) for (int rep = 0; rep < REP_MO; ++rep) merge_phase(l, smem); break;
    case 8: if (EN(8)) {
      GemmSpec g; g.A = p->qb; g.lda = 1024; g.Bt = p->wb + W_OUT; g.K = 1024; g.Nv = 1024;
      g.W = (const float*)p->in[21] + (long)l * 1048576; g.ldw = 1024; g.mapmode = 0; g.kscale = nullptr;
      for (int rep = 0; rep < REP_MO; ++rep) { EpiResid e{p->xres, rep == REP_MO - 1 ? 1.0f : 0.f}; gemm_phase(g, e, smem); }
    } break;
    case 9: for (int rep = 0; rep < REP_NORM; ++rep) if (EN(15)) norm_phase<false>(p->xres, (const float*)p->in[22] + l * DM, p->hb, nullptr); break;
  }
}

__global__ void __launch_bounds__(256, 2) mega(Params p) {
  extern __shared__ __attribute__((aligned(16))) char smem[];
  if (p.ph_lo < 0) cg::this_grid().sync();
#define GRID_SYNC(k) grid_barrier((unsigned*)(get_params()->counters + 256), (unsigned)(k))
#if PROBE
  volatile unsigned long long* tprevp = (volatile unsigned long long*)(smem + SMEM_ITEM + 16);
  volatile float* accp = (volatile float*)(smem + SMEM_ITEM + 32);
  if (threadIdx.x == 0) { *tprevp = wall_clock64(); accp[0] = 0.f; accp[1] = 0.f; }
#endif
  int ph0 = p.ph_lo, bofs = 0;
  if (ph0 == 0) {
    init_phase();
    ph0 = 1; bofs = 1;
  }
  for (int ph = ph0; ph < p.ph_hi; ++ph) {
    run_phase(ph, smem);
#if PROBE
    GRID_SYNC(ph - p.ph_lo);
    if (threadIdx.x == 0) {
      unsigned long long tn = wall_clock64();
      float dt = (float)(tn - *tprevp) * 0.01f;
      *tprevp = tn;
      float acc1 = 0.f, acc2 = 0.f;
      int j = (ph == 0 || ph == NPH - 1) ? 12 : (ph - 1) % 12;
      if (PROBE == 1) { if (j == 5) acc1 += dt; if (j == 6) acc2 += dt; }
      if (PROBE == 2) { if (j == 1 || j == 2 || j == 4 || j == 7 || j == 8 || j == 10 || j == 11) acc1 += dt; if (j == 0 || j == 3 || j == 9 || j == 12) acc2 += dt; }
      if (PROBE == 3) { if (j == 1 || j == 2 || j == 10 || j == 11) acc1 += dt; if (j == 4) acc2 += dt; }
      if (PROBE == 4) { if (j == 7) acc1 += dt; if (j == 8) acc2 += dt; }
      accp[0] += acc1; accp[1] += acc2;
    }
#else
    if (ph + 1 < p.ph_hi) GRID_SYNC(ph - p.ph_lo - bofs);
#endif
  }
#if PROBE
  {
    PP pp = get_params();
    float* slot = (float*)(pp->counters + 512);
    if (blockIdx.x == 0 && threadIdx.x == 0) { slot[0] = accp[0] * (1.f / 200.f); slot[1] = accp[1]; __threadfence(); }
    GRID_SYNC(p.ph_hi - p.ph_lo);
    float A = __hip_atomic_load(slot, __ATOMIC_RELAXED, __HIP_MEMORY_SCOPE_AGENT);
    float B = __hip_atomic_load(slot + 1, __ATOMIC_RELAXED, __HIP_MEMORY_SCOPE_AGENT);
    float* o = pp->xres;
    for (long i = (long)blockIdx.x * 256 + threadIdx.x; i < (long)T_TOK * DM; i += (long)gridDim.x * 256) o[i] = (i == 0) ? B : A;
  }
#endif
}

extern "C" void kernel_launch(void* const* d_in, const int* in_sizes, int n_in, void* d_out, int out_size, void* d_ws, size_t ws_size, hipStream_t stream) {
  static int grid = 0;
  if (!grid) {
    int dev = 0, cus = 0, per_cu = 0;
    hipGetDevice(&dev);
    hipDeviceGetAttribute(&cus, hipDeviceAttributeMultiprocessorCount, dev);
    hipFuncSetAttribute((const void*)mega, hipFuncAttributeMaxDynamicSharedMemorySize, SMEM_BYTES);
    hipOccupancyMaxActiveBlocksPerMultiprocessor(&per_cu, (const void*)mega, 256, SMEM_BYTES);
    if (per_cu < 1) per_cu = 1;
    if (per_cu > 2) per_cu = 2;
    grid = cus * per_cu;
  }
  char* ws = (char*)d_ws;
  size_t off = 0;
  auto take = [&](size_t bytes) { char* q = ws + off; off += (bytes + 255) & ~(size_t)255; return q; };
  Params p{};
  for (int i = 0; i < 26; ++i) p.in[i] = d_in[i];
  p.xres = (float*)d_out;
  p.counters = (int*)take(4096);
  p.cosb = (float*)take((size_t)T_TOK * 32 * 4);
  p.sinb = (float*)take((size_t)T_TOK * 32 * 4);
  p.wb = (bf16_t*)take((size_t)W_TOTAL * 2);
  p.hb = (bf16_t*)take((size_t)T_TOK * 1024 * 2);
  p.Y = (bf16_t*)take((size_t)T_TOK * NIN * 2);
  p.qb = (bf16_t*)take((size_t)T_TOK * 1536 * 2);
  p.kb = (bf16_t*)take((size_t)T_TOK * 1024 * 2);
  p.vtc = (bf16_t*)take((size_t)T_TOK * 1024 * 2);
  p.vtb = (bf16_t*)take((size_t)T_TOK * 1024 * 2);
  p.rgsum = (float*)take((size_t)NBATCH * 64 * 2048 * 4);
  if (off > ws_size) { fprintf(stderr, "kernel_launch: workspace too small: need %zu have %zu\n", off, ws_size); return; }
  hipMemsetAsync(p.counters, 0, 4096, stream);
#if SINGLE_LAUNCH
  p.ph_lo = 0; p.ph_hi = NPH;
  void* args[] = {&p};
  hipError_t e = hipLaunchCooperativeKernel((const void*)mega, dim3(grid), dim3(256), args, SMEM_BYTES, stream);
  if (e != hipSuccess) fprintf(stderr, "cooperative launch failed: %s (grid %d)\n", hipGetErrorString(e), grid);
#else
  for (int ph = 0; ph < NPH; ++ph) {
    p.ph_lo = ph; p.ph_hi = ph + 1;
    hipLaunchKernelGGL(mega, dim3(grid), dim3(256), SMEM_BYTES, stream, p);
  }
#endif
}
```

```cpp
#include <hip/hip_runtime.h>
#include <hip/hip_cooperative_groups.h>
#include <stdint.h>
#include <stdio.h>
namespace cg = cooperative_groups;

#ifndef NAIVE_GEMM
#define NAIVE_GEMM 0
#endif
#ifndef NAIVE_ATTN
#define NAIVE_ATTN 0
#endif
#ifndef NAIVE_RG
#define NAIVE_RG 0
#endif
#ifndef PH_MASK
#define PH_MASK 0xFFFFF
#endif
#define EN(j) ((PH_MASK >> (j)) & 1)
#ifndef REP_FFN
#define REP_FFN 1
#endif
#ifndef REP_WIN
#define REP_WIN 1
#endif
#ifndef REP_MO
#define REP_MO 1
#endif
#ifndef REP_SB
#define REP_SB 1
#endif
#ifndef REP_RG
#define REP_RG 1
#endif
#ifndef REP_UP
#define REP_UP 1
#endif
#ifndef REP_MLA
#define REP_MLA 1
#endif
#ifndef REP_NORM
#define REP_NORM 1
#endif
#ifndef PROBE
#define PROBE 0
#endif
#ifndef SINGLE_LAUNCH
#define SINGLE_LAUNCH 1
#endif

#define DI __device__ __forceinline__
typedef unsigned short bf16_t;
typedef __attribute__((ext_vector_type(8))) short bf16x8;
typedef __attribute__((ext_vector_type(16))) float f32x16;
typedef __attribute__((ext_vector_type(2))) __bf16 bf2v;
typedef __attribute__((ext_vector_type(2))) float f2v;
#define MFMA(a, b, c) __builtin_amdgcn_mfma_f32_32x32x16_bf16((a), (b), (c), 0, 0, 0)

constexpr int T_TOK = 16384, DM = 1024, SEQ = 4096, NBATCH = 4, DFF = 2816, NIN = 8768, DEPTH = 4;
constexpr int C_RGX = 0, C_RGG = 1024, C_SBQ = 2048, C_SBK = 3072, C_SBV = 4096, C_CQ = 5120, C_CKV = 5376, C_KR = 5632, C_GATE = 5696;
constexpr long W_GU1 = 0;
constexpr long W_D1 = W_GU1 + 5632L * 1024;
constexpr long W_IN = W_D1 + 1024L * 2816;
constexpr long W_UQ = W_IN + 8768L * 1024;
constexpr long W_UKV = W_UQ + 1536L * 256;
constexpr long W_BA = W_UKV + 2048L * 256;
constexpr long W_BB = W_BA + 1024L * 1024;
constexpr long W_BC = W_BB + 1024L * 1024;
constexpr long W_OUT = W_BC + 1024L * 1024;
constexpr long W_GU2 = W_OUT + 1024L * 1024;
constexpr long W_D2 = W_GU2 + 5632L * 1024;
constexpr long W_RGA = W_D2 + 1024L * 2816;
constexpr long W_RGX = W_RGA + 65536;
constexpr long W_TOTAL = W_RGX + 65536;

constexpr int NPH = 50;
constexpr int SMEM_GEMM = 2 * 2 * 128 * 72 * 2;
constexpr int SMEM_RINV = SMEM_GEMM;
constexpr int SMEM_ITEM = SMEM_GEMM + 512;
constexpr int SMEM_BYTES = SMEM_GEMM + 512 + 64;

struct Params {
  const void* in[26];
  float* xres;
  bf16_t* wb;
  bf16_t* hb;
  bf16_t* Y;
  bf16_t* qb;
  bf16_t* kb;
  bf16_t* vtc;
  bf16_t* vtb;
  float* cosb;
  float* sinb;
  int* counters;
  float* rgsum;
  int ph_lo, ph_hi;
};

typedef const Params __attribute__((address_space(4)))* PP;
__device__ __forceinline__ PP get_params() { PP q = (PP)__builtin_amdgcn_kernarg_segment_ptr(); asm volatile("" : "+s"(q)); return q; }
__device__ __forceinline__ int otid() { int t = threadIdx.x; asm volatile("" : "+v"(t)); return t; }
DI unsigned pack2(float a, float b) { f2v v = {a, b}; bf2v r = __builtin_convertvector(v, bf2v); return __builtin_bit_cast(unsigned, r); }
DI bf16_t f2bf(float a) { return (bf16_t)(pack2(a, 0.f) & 0xffffu); }
DI float bf2f(bf16_t v) { return __uint_as_float(((unsigned)v) << 16); }
DI float bflo(unsigned u) { return __uint_as_float(u << 16); }
DI float bfhi(unsigned u) { return __uint_as_float(u & 0xffff0000u); }
DI int crow(int i, int h) { return (i & 3) + 8 * (i >> 2) + 4 * h; }
DI float sigmoidf_(float x) { return 1.f / (1.f + __expf(-x)); }
DI float gelu_tanh(float x) { float u = 0.7978845608028654f * (x + 0.044715f * x * x * x); return x / (1.f + __expf(-2.f * u)); }
DI void store4bf(bf16_t* p, const float (&v)[4]) { uint2 u; u.x = pack2(v[0], v[1]); u.y = pack2(v[2], v[3]); *(uint2*)p = u; }

struct GemmSpec {
  const bf16_t* A; int lda;
  const bf16_t* Bt; int K;
  int Nv;
  const float* W; int ldw;
  int mapmode;
  const float* kscale;
};
DI int wcol(int mode, int n) {
  if (mode == 0) return n;
  int blk = n >> 6, which = (n >> 5) & 1, j = blk * 32 + (n & 31);
  return which * DFF + j;
}

constexpr int LROW = 72;

template <int NI, int DEPTH, int PIPE = 1>
DI void gemm_main(const GemmSpec& g, int m0, int n0, f32x16 (&acc)[2][NI], char* smem) {
  const int tid = otid(), lane = tid & 63, wave = tid >> 6;
  const int r = lane & 31, hh = lane >> 5, wm = wave >> 1, wn = wave & 1;
#pragma unroll
  for (int a = 0; a < 2; ++a)
#pragma unroll
    for (int b = 0; b < NI; ++b)
#pragma unroll
      for (int i = 0; i < 16; ++i) acc[a][b][i] = 0.f;
  __syncthreads();
#if !NAIVE_GEMM
  bf16_t* sA = (bf16_t*)smem;
  bf16_t* sB = sA + 2 * 128 * LROW;
  const int srow = tid >> 3, skc = tid & 7;
  const bf16_t* Ap = g.A + (long)(m0 + srow) * g.lda + skc * 8;
  const bf16_t* Bp0 = g.Bt + (long)(n0 + srow) * g.K + skc * 8;
  const long ldb32 = (long)32 * g.K;
  const long lda32 = (long)32 * g.lda;
  uint4 a00, a01, a02, a03, b00, b01, b02, b03, a10, a11, a12, a13, b10, b11, b12, b13, a20, a21, a22, a23, b20, b21, b22, b23;
  b02 = b03 = b12 = b13 = b22 = b23 = make_uint4(0u, 0u, 0u, 0u);
  const int KT = g.K >> 6;
  bf16_t* wA = sA + srow * LROW + skc * 8;
  bf16_t* wB = sB + srow * LROW + skc * 8;
#define G_LOAD(S, KTILE) { const int ko = (KTILE) * 64; \
    a##S##0 = *(const uint4*)(Ap + ko); a##S##1 = *(const uint4*)(Ap + lda32 + ko); a##S##2 = *(const uint4*)(Ap + 2 * lda32 + ko); a##S##3 = *(const uint4*)(Ap + 3 * lda32 + ko); \
    b##S##0 = *(const uint4*)(Bp0 + ko); b##S##1 = *(const uint4*)(Bp0 + ldb32 + ko); \
    if (NI == 2) { b##S##2 = *(const uint4*)(Bp0 + 2 * ldb32 + ko); b##S##3 = *(const uint4*)(Bp0 + 3 * ldb32 + ko); } }
#define G_STORE(S, BUF) { bf16_t* pa = wA + (BUF) * 128 * LROW; bf16_t* pb = wB + (BUF) * (64 * NI) * LROW; \
    *(uint4*)(pa) = a##S##0; *(uint4*)(pa + 32 * LROW) = a##S##1; *(uint4*)(pa + 64 * LROW) = a##S##2; *(uint4*)(pa + 96 * LROW) = a##S##3; \
    *(uint4*)(pb) = b##S##0; *(uint4*)(pb + 32 * LROW) = b##S##1; \
    if (NI == 2) { *(uint4*)(pb + 64 * LROW) = b##S##2; *(uint4*)(pb + 96 * LROW) = b##S##3; } }
#define G_FRAGS(KK, BF, AF) { \
    _Pragma("unroll") for (int ni = 0; ni < NI; ++ni) BF[ni] = *(const bf16x8*)(cB + ni * 32 * LROW + (KK) * 16); \
    _Pragma("unroll") for (int mi = 0; mi < 2; ++mi) AF[mi] = *(const bf16x8*)(cA + mi * 32 * LROW + (KK) * 16); }
#define G_MMA(BF, AF) { \
    __builtin_amdgcn_s_setprio(1); \
    _Pragma("unroll") for (int mi = 0; mi < 2; ++mi) \
      _Pragma("unroll") for (int ni = 0; ni < NI; ++ni) acc[mi][ni] = MFMA(BF[ni], AF[mi], acc[mi][ni]); \
    __builtin_amdgcn_s_setprio(0); \
    __builtin_amdgcn_sched_barrier(0); }
#define G_COMPUTE(BUF) { \
    const bf16_t* cA = sA + (BUF) * 128 * LROW + (wm * 64 + r) * LROW + hh * 8; \
    const bf16_t* cB = sB + (BUF) * (64 * NI) * LROW + (wn * 32 * NI + r) * LROW + hh * 8; \
    bf16x8 bf0[NI], af0[2], bf1[NI], af1[2]; \
    G_FRAGS(0, bf0, af0) \
    G_FRAGS(1, bf1, af1) \
    __builtin_amdgcn_sched_barrier(0); \
    G_MMA(bf0, af0) \
    G_FRAGS(2, bf0, af0) \
    __builtin_amdgcn_sched_barrier(0); \
    G_MMA(bf1, af1) \
    G_FRAGS(3, bf1, af1) \
    __builtin_amdgcn_sched_barrier(0); \
    G_MMA(bf0, af0) \
    G_MMA(bf1, af1) }
#define G_COMPUTE_SIMPLE(BUF) { \
    const bf16_t* cA = sA + (BUF) * 128 * LROW + (wm * 64 + r) * LROW + hh * 8; \
    const bf16_t* cB = sB + (BUF) * (64 * NI) * LROW + (wn * 32 * NI + r) * LROW + hh * 8; \
    _Pragma("unroll") for (int kk = 0; kk < 4; ++kk) { \
      bf16x8 bfr[NI], afr[2]; \
      _Pragma("unroll") for (int ni = 0; ni < NI; ++ni) bfr[ni] = *(const bf16x8*)(cB + ni * 32 * LROW + kk * 16); \
      _Pragma("unroll") for (int mi = 0; mi < 2; ++mi) afr[mi] = *(const bf16x8*)(cA + mi * 32 * LROW + kk * 16); \
      _Pragma("unroll") for (int mi = 0; mi < 2; ++mi) \
        _Pragma("unroll") for (int ni = 0; ni < NI; ++ni) acc[mi][ni] = MFMA(bfr[ni], afr[mi], acc[mi][ni]); \
    } }
#define G_COMPUTE_ST(BUF, S, NB, DO, DOL, KL) { \
    const bf16_t* cA = sA + (BUF) * 128 * LROW + (wm * 64 + r) * LROW + hh * 8; \
    const bf16_t* cB = sB + (BUF) * (64 * NI) * LROW + (wn * 32 * NI + r) * LROW + hh * 8; \
    bf16_t* pa = wA + (NB) * 128 * LROW; bf16_t* pb = wB + (NB) * (64 * NI) * LROW; \
    const int ko = (KL) * 64; \
    bf16x8 bf0[NI], af0[2], bf1[NI], af1[2], bf2[NI], af2[2]; \
    G_FRAGS(0, bf0, af0) \
    G_FRAGS(1, bf1, af1) \
    G_FRAGS(2, bf2, af2) \
    __builtin_amdgcn_sched_barrier(0); \
    G_MMA(bf0, af0) \
    G_FRAGS(3, bf0, af0) \
    if (DO) { *(uint4*)(pa) = a##S##0; } \
    if (DOL) { a##S##0 = *(const uint4*)(Ap + ko); } \
    __builtin_amdgcn_sched_barrier(0); \
    G_MMA(bf1, af1) \
    if (DO) { *(uint4*)(pa + 32 * LROW) = a##S##1; *(uint4*)(pa + 64 * LROW) = a##S##2; } \
    if (DOL) { a##S##1 = *(const uint4*)(Ap + lda32 + ko); a##S##2 = *(const uint4*)(Ap + 2 * lda32 + ko); } \
    __builtin_amdgcn_sched_barrier(0); \
    G_MMA(bf2, af2) \
    if (DO) { *(uint4*)(pa + 96 * LROW) = a##S##3; *(uint4*)(pb) = b##S##0; } \
    if (DOL) { a##S##3 = *(const uint4*)(Ap + 3 * lda32 + ko); b##S##0 = *(const uint4*)(Bp0 + ko); } \
    __builtin_amdgcn_sched_barrier(0); \
    G_MMA(bf0, af0) \
    if (DO) { *(uint4*)(pb + 32 * LROW) = b##S##1; if (NI == 2) { *(uint4*)(pb + 64 * LROW) = b##S##2; *(uint4*)(pb + 96 * LROW) = b##S##3; } } \
    if (DOL) { b##S##1 = *(const uint4*)(Bp0 + ldb32 + ko); if (NI == 2) { b##S##2 = *(const uint4*)(Bp0 + 2 * ldb32 + ko); b##S##3 = *(const uint4*)(Bp0 + 3 * ldb32 + ko); } } \
    __builtin_amdgcn_sched_barrier(0); }
#define G_COMPUTE_ST1(BUF, S, NB, DO, DOL, KL) { \
    const bf16_t* cA = sA + (BUF) * 128 * LROW + (wm * 64 + r) * LROW + hh * 8; \
    const bf16_t* cB = sB + (BUF) * (64 * NI) * LROW + (wn * 32 * NI + r) * LROW + hh * 8; \
    bf16_t* pa = wA + (NB) * 128 * LROW; bf16_t* pb = wB + (NB) * (64 * NI) * LROW; \
    const int ko = (KL) * 64; \
    bf16x8 bf0[NI], af0[2]; \
    G_FRAGS(0, bf0, af0) \
    __builtin_amdgcn_sched_barrier(0); \
    G_MMA(bf0, af0) \
    G_FRAGS(1, bf0, af0) \
    if (DO) { *(uint4*)(pa) = a##S##0; *(uint4*)(pa + 32 * LROW) = a##S##1; } \
    if (DOL) { a##S##0 = *(const uint4*)(Ap + ko); a##S##1 = *(const uint4*)(Ap + lda32 + ko); } \
    __builtin_amdgcn_sched_barrier(0); \
    G_MMA(bf0, af0) \
    G_FRAGS(2, bf0, af0) \
    if (DO) { *(uint4*)(pa + 64 * LROW) = a##S##2; *(uint4*)(pa + 96 * LROW) = a##S##3; } \
    if (DOL) { a##S##2 = *(const uint4*)(Ap + 2 * lda32 + ko); a##S##3 = *(const uint4*)(Ap + 3 * lda32 + ko); } \
    __builtin_amdgcn_sched_barrier(0); \
    G_MMA(bf0, af0) \
    G_FRAGS(3, bf0, af0) \
    if (DO) { *(uint4*)(pb) = b##S##0; *(uint4*)(pb + 32 * LROW) = b##S##1; } \
    if (DOL) { b##S##0 = *(const uint4*)(Bp0 + ko); b##S##1 = *(const uint4*)(Bp0 + ldb32 + ko); } \
    __builtin_amdgcn_sched_barrier(0); \
    G_MMA(bf0, af0) \
    if (NI == 2) { if (DO) { *(uint4*)(pb + 64 * LROW) = b##S##2; *(uint4*)(pb + 96 * LROW) = b##S##3; } \
                   if (DOL) { b##S##2 = *(const uint4*)(Bp0 + 2 * ldb32 + ko); b##S##3 = *(const uint4*)(Bp0 + 3 * ldb32 + ko); } } \
    __builtin_amdgcn_sched_barrier(0); }
  if (DEPTH == 3) {
  G_LOAD(0, 0)
  G_LOAD(1, 1)
  if (KT > 2) G_LOAD(2, 2)
  G_STORE(0, 0)
  if (KT > 3) G_LOAD(0, 3)
  __syncthreads();
#define G_STEP(I, SN) { if (kt + (I) >= KT) break; \
    G_COMPUTE((I) & 1) \
    if (kt + (I) + 1 < KT) { G_STORE(SN, ((I) + 1) & 1) if (kt + (I) + 4 < KT) G_LOAD(SN, kt + (I) + 4) } \
    __syncthreads(); }
  for (int kt = 0; kt < KT; kt += 6) {
    G_STEP(0, 1)
    G_STEP(1, 2)
    G_STEP(2, 0)
    G_STEP(3, 1)
    G_STEP(4, 2)
    G_STEP(5, 0)
  }
#undef G_STEP
  } else {
  G_LOAD(0, 0)
  G_LOAD(1, 1)
  G_STORE(0, 0)
  if (KT > 2) G_LOAD(0, 2)
  __syncthreads();
  for (int kt = 0; kt < KT; kt += 2) {
    const bool l3 = kt + 3 < KT, more = kt + 2 < KT, l4 = kt + 4 < KT;
    if (PIPE == 1) { G_COMPUTE_ST(0, 1, 1, true, l3, kt + 3) } else if (PIPE == 2) { G_COMPUTE_ST1(0, 1, 1, true, l3, kt + 3) } else { G_COMPUTE_SIMPLE(0) G_STORE(1, 1) if (l3) G_LOAD(1, kt + 3) }
    __syncthreads();
    if (PIPE == 1) { G_COMPUTE_ST(1, 0, 0, more, l4, kt + 4) } else if (PIPE == 2) { G_COMPUTE_ST1(1, 0, 0, more, l4, kt + 4) } else { G_COMPUTE_SIMPLE(1) if (more) G_STORE(0, 0) if (l4) G_LOAD(0, kt + 4) }
    __syncthreads();
  }
  }
#else
  float* As = (float*)smem;
  float* Ws = As + 128 * 17;
  for (int k0 = 0; k0 < g.K; k0 += 16) {
    {
      int row = tid >> 1, half = tid & 1;
      uint4 v = *(const uint4*)(g.A + (long)(m0 + row) * g.lda + k0 + half * 8);
      float* d = As + row * 17 + half * 8;
      d[0] = bflo(v.x); d[1] = bfhi(v.x); d[2] = bflo(v.y); d[3] = bfhi(v.y); d[4] = bflo(v.z); d[5] = bfhi(v.z); d[6] = bflo(v.w); d[7] = bfhi(v.w);
      int kk = tid >> 4, c8 = (tid & 15) * 4 * NI;
      float ks = g.kscale ? g.kscale[k0 + kk] : 1.f;
#pragma unroll
      for (int q = 0; q < NI; ++q) {
        int n = n0 + c8 + q * 4;
        float4 w = make_float4(0.f, 0.f, 0.f, 0.f);
        if (n < g.Nv) w = *(const float4*)(g.W + (long)(k0 + kk) * g.ldw + wcol(g.mapmode, n));
        float* dw = Ws + kk * (64 * NI) + c8 + q * 4;
        dw[0] = w.x * ks; dw[1] = w.y * ks; dw[2] = w.z * ks; dw[3] = w.w * ks;
      }
    }
    __syncthreads();
#pragma unroll 1
    for (int k = 0; k < 16; ++k) {
#pragma unroll
      for (int mi = 0; mi < 2; ++mi) {
        float a = As[(wm * 64 + mi * 32 + r) * 17 + k];
#pragma unroll
        for (int ni = 0; ni < NI; ++ni)
#pragma unroll
          for (int gq = 0; gq < 4; ++gq) {
            float4 w = *(const float4*)(Ws + k * (64 * NI) + wn * 32 * NI + ni * 32 + 8 * gq + 4 * hh);
            acc[mi][ni][4 * gq + 0] += a * w.x; acc[mi][ni][4 * gq + 1] += a * w.y; acc[mi][ni][4 * gq + 2] += a * w.z; acc[mi][ni][4 * gq + 3] += a * w.w;
          }
      }
    }
    __syncthreads();
  }
#endif
}

struct EpiDest { int type; void* base; long stride; };
constexpr int STG_F32_PITCH = 272;
constexpr int STG_WAVE = 64 * STG_F32_PITCH;
constexpr int STG_BF_PITCH = 144;
constexpr int STG_BF32_PITCH = 80;

template <class Epi>
DI void gemm_epi(f32x16 (&acc)[2][2], int m0, int n0, int Nv, Epi& epi, char* smem) {
  const int lane = otid() & 63, wave = otid() >> 6;
  const int r = lane & 31, hh = lane >> 5, wm = wave >> 1, wn = wave & 1;
  const int nw = n0 + wn * 64, mw = m0 + wm * 64;
  if (nw >= Nv) return;
  char* stg = smem + wave * STG_WAVE;
  const EpiDest d = epi.dest(mw, nw);
#pragma unroll
  for (int mi = 0; mi < 2; ++mi)
#pragma unroll
    for (int gq = 0; gq < 4; ++gq) {
      float v0[4], v1[4], o0[4], o1[4];
#pragma unroll
      for (int j = 0; j < 4; ++j) { v0[j] = acc[mi][0][4 * gq + j]; v1[j] = acc[mi][1][4 * gq + j]; }
      epi.compute(mw + mi * 32 + r, nw + 8 * gq + 4 * hh, v0, v1, o0, o1);
      const int row = mi * 32 + r, col = 8 * gq + 4 * hh;
      if (d.type == 0) {
        uint2 u0, u1; u0.x = pack2(o0[0], o0[1]); u0.y = pack2(o0[2], o0[3]); u1.x = pack2(o1[0], o1[1]); u1.y = pack2(o1[2], o1[3]);
        *(uint2*)(stg + row * STG_BF_PITCH + col * 2) = u0; *(uint2*)(stg + row * STG_BF_PITCH + (col + 32) * 2) = u1;
      } else if (d.type == 1) {
        uint2 u0; u0.x = pack2(o0[0], o0[1]); u0.y = pack2(o0[2], o0[3]);
        *(uint2*)(stg + row * STG_BF32_PITCH + col * 2) = u0;
      } else if (d.type == 2) {
#pragma unroll
        for (int j = 0; j < 4; ++j) {
          *(bf16_t*)(stg + (col + j) * STG_BF_PITCH + row * 2) = f2bf(o0[j]);
          *(bf16_t*)(stg + (col + 32 + j) * STG_BF_PITCH + row * 2) = f2bf(o1[j]);
        }
      } else {
        *(float4*)(stg + row * STG_F32_PITCH + col * 4) = make_float4(o0[0], o0[1], o0[2], o0[3]);
        *(float4*)(stg + row * STG_F32_PITCH + (col + 32) * 4) = make_float4(o1[0], o1[1], o1[2], o1[3]);
      }
    }
  __builtin_amdgcn_wave_barrier();
  asm volatile("s_waitcnt lgkmcnt(0)" ::: "memory");
  typedef unsigned v4u_t __attribute__((ext_vector_type(4)));
  const __amdgpu_buffer_rsrc_t rs = __builtin_amdgcn_make_buffer_rsrc(d.base, 0, 0x7ffffff0, 0x00020000);
  if (d.type == 0 || d.type == 2) {
    const int rr = lane >> 3, ch = lane & 7;
#pragma unroll
    for (int it = 0; it < 8; ++it) {
      const int row = it * 8 + rr;
      uint4 v = *(const uint4*)(stg + row * STG_BF_PITCH + ch * 16);
      __builtin_amdgcn_raw_buffer_store_b128(__builtin_bit_cast(v4u_t, v), rs, (unsigned)(((long)row * d.stride + ch * 8) * 2), 0, 16);
    }
  } else if (d.type == 1) {
    const int rr = lane >> 2, ch = lane & 3;
#pragma unroll
    for (int it = 0; it < 4; ++it) {
      const int row = it * 16 + rr;
      uint4 v = *(const uint4*)(stg + row * STG_BF32_PITCH + ch * 16);
      __builtin_amdgcn_raw_buffer_store_b128(__builtin_bit_cast(v4u_t, v), rs, (unsigned)(((long)row * d.stride + ch * 8) * 2), 0, 16);
    }
  } else {
    float* base = (float*)d.base;
    const int rr = lane >> 4, ch = lane & 15;
#pragma unroll
    for (int it = 0; it < 16; ++it) {
      const int row = it * 4 + rr;
      float4 sv = *(const float4*)(stg + row * STG_F32_PITCH + ch * 16);
      float4* gp = (float4*)(base + (long)row * d.stride + ch * 4);
      typedef float f4r_t __attribute__((ext_vector_type(4)));
      const f4r_t xl = __builtin_nontemporal_load((const f4r_t*)gp);
      float4 xv = make_float4(xl.x, xl.y, xl.z, xl.w);
      xv.x += sv.x; xv.y += sv.y; xv.z += sv.z; xv.w += sv.w;
      __builtin_amdgcn_raw_buffer_store_b128(__builtin_bit_cast(v4u_t, xv), rs, (unsigned)(((long)row * d.stride + ch * 4) * 4), 0, 16);
    }
  }
  __builtin_amdgcn_wave_barrier();
}

struct EpiSwiglu {
  bf16_t* act;
  DI EpiDest dest(int mw, int nw) const { return EpiDest{1, act + (long)mw * DFF + (nw >> 6) * 32, DFF}; }
  DI void compute(int, int, const float (&v0)[4], const float (&v1)[4], float (&o0)[4], float (&o1)[4]) const {
#pragma unroll
    for (int j = 0; j < 4; ++j) { o0[j] = v0[j] * sigmoidf_(v0[j]) * v1[j]; o1[j] = 0.f; }
  }
};
struct EpiResid {
  float* x; float scale;
  DI EpiDest dest(int mw, int nw) const { return EpiDest{3, x + (long)mw * DM + nw, DM}; }
  DI void compute(int, int, const float (&v0)[4], const float (&v1)[4], float (&o0)[4], float (&o1)[4]) const {
#pragma unroll
    for (int j = 0; j < 4; ++j) { o0[j] = scale * v0[j]; o1[j] = scale * v1[j]; }
  }
};
struct EpiWin {
  bf16_t* Y; bf16_t* vtb; const float* cosb; const float* sinb;
  DI EpiDest dest(int mw, int nw) const {
    if (nw >= C_SBV && nw < C_CQ) {
      const int c = nw - C_SBV, head = c >> 7, d0 = c & 127, b = mw >> 12, s0 = mw & 4095;
      return EpiDest{2, vtb + ((long)((b * 8 + head) * 128 + d0)) * SEQ + s0, SEQ};
    }
    return EpiDest{0, Y + (long)mw * NIN + nw, NIN};
  }
  DI void compute(int m, int n, const float (&v0)[4], const float (&v1)[4], float (&o0)[4], float (&o1)[4]) const {
    if ((n & ~63) == C_KR) {
      const int i0 = n - C_KR;
      float4 c = *(const float4*)(cosb + (long)m * 32 + i0), s = *(const float4*)(sinb + (long)m * 32 + i0);
      const float cc[4] = {c.x, c.y, c.z, c.w}, ss[4] = {s.x, s.y, s.z, s.w};
#pragma unroll
      for (int j = 0; j < 4; ++j) { o0[j] = v0[j] * cc[j] - v1[j] * ss[j]; o1[j] = v1[j] * cc[j] + v0[j] * ss[j]; }
    } else {
#pragma unroll
      for (int j = 0; j < 4; ++j) { o0[j] = v0[j]; o1[j] = v1[j]; }
    }
  }
};
struct EpiQ {
  bf16_t* qb; const float* rinv; int m0; const float* cosb; const float* sinb;
  DI EpiDest dest(int mw, int nw) const { return EpiDest{0, qb + (long)mw * 1536 + nw, 1536}; }
  DI void compute(int m, int n, const float (&v0)[4], const float (&v1)[4], float (&o0)[4], float (&o1)[4]) const {
    const float ri = rinv[m - m0];
    const int nb = n & ~63;
    if ((nb % 192) == 128) {
      const int i0 = n - nb;
      float4 c = *(const float4*)(cosb + (long)m * 32 + i0), s = *(const float4*)(sinb + (long)m * 32 + i0);
      const float cc[4] = {c.x, c.y, c.z, c.w}, ss[4] = {s.x, s.y, s.z, s.w};
#pragma unroll
      for (int j = 0; j < 4; ++j) { float a = v0[j] * ri, b = v1[j] * ri; o0[j] = a * cc[j] - b * ss[j]; o1[j] = b * cc[j] + a * ss[j]; }
    } else {
#pragma unroll
      for (int j = 0; j < 4; ++j) { o0[j] = v0[j] * ri; o1[j] = v1[j] * ri; }
    }
  }
};
struct EpiKV {
  bf16_t* kb; bf16_t* vtc; const float* rinv; int m0;
  DI EpiDest dest(int mw, int nw) const {
    const int head = nw >> 8, w = nw & 255;
    if (w < 128) return EpiDest{0, kb + (long)mw * 1024 + head * 128 + w, 1024};
    const int b = mw >> 12, s0 = mw & 4095;
    return EpiDest{2, vtc + ((long)((b * 8 + head) * 128 + (w - 128))) * SEQ + s0, SEQ};
  }
  DI void compute(int m, int, const float (&v0)[4], const float (&v1)[4], float (&o0)[4], float (&o1)[4]) const {
    const float ri = rinv[m - m0];
#pragma unroll
    for (int j = 0; j < 4; ++j) { o0[j] = v0[j] * ri; o1[j] = v1[j] * ri; }
  }
};

DI void conv_tile(const float* src, int ldsrc, int k0, int n0, bf16_t* dst, int ldd, int mode, const float* kscale, char* smem) {
  float* tile = (float*)smem;
  const int tid = otid();
  __syncthreads();
#pragma unroll
  for (int i = 0; i < 4; ++i) {
    int kk = (tid >> 4) + 16 * i, nn = (tid & 15) * 4;
    typedef float f4v_t __attribute__((ext_vector_type(4)));
    const f4v_t v = __builtin_nontemporal_load((const f4v_t*)(src + (long)(k0 + kk) * ldsrc + n0 + nn));
    float s = kscale ? kscale[k0 + kk] : 1.f;
    tile[(nn + 0) * 65 + kk] = v.x * s; tile[(nn + 1) * 65 + kk] = v.y * s; tile[(nn + 2) * 65 + kk] = v.z * s; tile[(nn + 3) * 65 + kk] = v.w * s;
  }
  __syncthreads();
  {
    int nn = tid >> 2, ks = (tid & 3) * 16;
    const float* t = tile + nn * 65 + ks;
    uint4 a, b;
    a.x = pack2(t[0], t[1]); a.y = pack2(t[2], t[3]); a.z = pack2(t[4], t[5]); a.w = pack2(t[6], t[7]);
    b.x = pack2(t[8], t[9]); b.y = pack2(t[10], t[11]); b.z = pack2(t[12], t[13]); b.w = pack2(t[14], t[15]);
    int n = n0 + nn, drow;
    if (mode == 0) drow = n;
    else { int which = n >= DFF ? 1 : 0, j = n - which * DFF; drow = (j >> 5) * 64 + which * 32 + (j & 31); }
    bf16_t* d = dst + (long)drow * ldd + k0 + ks;
    *(uint4*)d = a; *(uint4*)(d + 8) = b;
  }
}

DI void convert_layer(int l, char* smem) {
  PP p = get_params();
  const int nGU = 1408, nD = 704, nIN = 2192, nUQ = 96, nUKV = 128, nSQ = 256, nRG = 16;
  const int total = 2 * nGU + 2 * nD + nIN + nUQ + nUKV + 4 * nSQ + 2 * nRG;
  bf16_t* wb = p->wb;
  for (int t = blockIdx.x; t < total; t += gridDim.x) {
    int u = t;
    const float* src; int K, N; bf16_t* dst; int mode = 0; const float* ks = nullptr;
    if (u < nGU) { src = (const float*)p->in[3] + (long)l * 1024 * 5632; K = 1024; N = 5632; dst = wb + W_GU1; mode = 1; }
    else if ((u -= nGU) < nD) { src = (const float*)p->in[4] + (long)l * 2816 * 1024; K = 2816; N = 1024; dst = wb + W_D1; }
    else if ((u -= nD) < nIN) { src = (const float*)p->in[6] + (long)l * 1024 * 8768; K = 1024; N = 8768; dst = wb + W_IN; }
    else if ((u -= nIN) < nUQ) { src = (const float*)p->in[15] + (long)l * 256 * 1536; K = 256; N = 1536; dst = wb + W_UQ; ks = (const float*)p->in[14] + l * 256; }
    else if ((u -= nUQ) < nUKV) { src = (const float*)p->in[17] + (long)l * 256 * 2048; K = 256; N = 2048; dst = wb + W_UKV; ks = (const float*)p->in[16] + l * 256; }
    else if ((u -= nUKV) < nSQ) { src = (const float*)p->in[18] + (long)l * 1024 * 1024; K = 1024; N = 1024; dst = wb + W_BA; }
    else if ((u -= nSQ) < nSQ) { src = (const float*)p->in[19] + (long)l * 1024 * 1024; K = 1024; N = 1024; dst = wb + W_BB; }
    else if ((u -= nSQ) < nSQ) { src = (const float*)p->in[20] + (long)l * 1024 * 1024; K = 1024; N = 1024; dst = wb + W_BC; }
    else if ((u -= nSQ) < nSQ) { src = (const float*)p->in[21] + (long)l * 1024 * 1024; K = 1024; N = 1024; dst = wb + W_OUT; }
    else if ((u -= nSQ) < nGU) { src = (const float*)p->in[23] + (long)l * 1024 * 5632; K = 1024; N = 5632; dst = wb + W_GU2; mode = 1; }
    else if ((u -= nGU) < nD) { src = (const float*)p->in[24] + (long)l * 2816 * 1024; K = 2816; N = 1024; dst = wb + W_D2; }
    else if ((u -= nD) < nRG) { src = (const float*)p->in[9] + (long)l * 65536 + (long)u * 4096; K = 64; N = 64; dst = wb + W_RGA + (long)u * 4096; u = 0; }
    else { u -= nRG; src = (const float*)p->in[11] + (long)l * 65536 + (long)u * 4096; K = 64; N = 64; dst = wb + W_RGX + (long)u * 4096; u = 0; }
    int ntn = N >> 6;
    int kt = u / ntn, nt = u - kt * ntn;
    conv_tile(src, N, kt * 64, nt * 64, dst, K, mode, ks, smem);
  }
}

template <bool FINAL>
DI void norm_phase(const float* x, const float* g, bf16_t* outb, float* outf) {
  const int lane = otid() & 63;
  const int gw = blockIdx.x * 4 + (otid() >> 6), nw = gridDim.x * 4;
  float4 gg[4];
#pragma unroll
  for (int i = 0; i < 4; ++i) gg[i] = *(const float4*)(g + lane * 4 + 256 * i);
  for (int row = gw; row < T_TOK; row += nw) {
    const float* xr = x + (long)row * DM;
    float4 v[4]; float ss = 0.f;
#pragma unroll
    for (int i = 0; i < 4; ++i) { v[i] = *(const float4*)(xr + lane * 4 + 256 * i); ss += v[i].x * v[i].x + v[i].y * v[i].y + v[i].z * v[i].z + v[i].w * v[i].w; }
#pragma unroll
    for (int o = 32; o >= 1; o >>= 1) ss += __shfl_xor(ss, o);
    const float ri = rsqrtf(ss * (1.f / 1024.f) + 1e-6f);
#pragma unroll
    for (int i = 0; i < 4; ++i) {
      float o[4] = {v[i].x * ri * gg[i].x, v[i].y * ri * gg[i].y, v[i].z * ri * gg[i].z, v[i].w * ri * gg[i].w};
      if (FINAL) *(float4*)(outf + (long)row * DM + lane * 4 + 256 * i) = make_float4(o[0], o[1], o[2], o[3]);
      else store4bf(outb + (long)row * DM + lane * 4 + 256 * i, o);
    }
  }
}

template <class Epi>
DI void gemm_phase(const GemmSpec& g, Epi& epi, char* smem) {
  const int ntn = (g.Nv + 127) >> 7, ntm = T_TOK >> 7;
  const int G = gridDim.x;
  const bool xo = (G & 7) == 0;
  const int band = xo ? ntm >> 3 : ntm, ustep = xo ? G >> 3 : G, u0 = xo ? (int)(blockIdx.x >> 3) : (int)blockIdx.x, mbase = xo ? (int)(blockIdx.x & 7) * band : 0;
  const int utot = band * ntn;
#if NAIVE_GEMM
  for (int u = u0; u < utot; u += ustep) {
    int nt = u / band, mt = mbase + (u - nt * band);
    f32x16 acc[2][2];
    gemm_main<2, 2>(g, mt * 128, nt * 128, acc, smem);
    gemm_epi(acc, mt * 128, nt * 128, g.Nv, epi, smem);
  }
#else
  constexpr int NI = 2;
  const int tid = otid(), lane = tid & 63, wave = tid >> 6;
  const int r = lane & 31, hh = lane >> 5, wm = wave >> 1, wn = wave & 1;
  bf16_t* sA = (bf16_t*)smem;
  bf16_t* sB = sA + 2 * 128 * LROW;
  const int srow = tid >> 3, skc = tid & 7;
  const long lda32 = (long)32 * g.lda, ldb32 = (long)32 * g.K;
  const int KT = g.K >> 6;
  bf16_t* wA = sA + srow * LROW + skc * 8;
  bf16_t* wB = sB + srow * LROW + skc * 8;
  uint4 a00, a01, a02, a03, b00, b01, b02, b03, a10, a11, a12, a13, b10, b11, b12, b13;
  const bf16_t* Ap = g.A;
  const bf16_t* Bp0 = g.Bt;
  int u = u0;
  if (u < utot) {
    const int nt = u / band, mt = mbase + (u - nt * band);
    Ap = g.A + (long)(mt * 128 + srow) * g.lda + skc * 8;
    Bp0 = g.Bt + (long)(nt * 128 + srow) * g.K + skc * 8;
    G_LOAD(0, 0)
    G_LOAD(1, 1)
  }
  for (; u < utot; u += ustep) {
    const int nt = u / band, mt = mbase + (u - nt * band), m0 = mt * 128, n0 = nt * 128;
    f32x16 acc[2][2];
#pragma unroll
    for (int a = 0; a < 2; ++a)
#pragma unroll
      for (int b = 0; b < 2; ++b)
#pragma unroll
        for (int i = 0; i < 16; ++i) acc[a][b][i] = 0.f;
    __syncthreads();
    G_STORE(0, 0)
    if (KT > 2) G_LOAD(0, 2)
    __syncthreads();
    for (int kt = 0; kt < KT; kt += 2) {
      const bool l3 = kt + 3 < KT, more = kt + 2 < KT, l4 = kt + 4 < KT;
      G_COMPUTE_ST(0, 1, 1, true, l3, kt + 3)
      __syncthreads();
      G_COMPUTE_ST(1, 0, 0, more, l4, kt + 4)
      __syncthreads();
    }
    const int un = u + ustep;
    if (un < utot) {
      const int nt2 = un / band, mt2 = mbase + (un - nt2 * band);
      Ap = g.A + (long)(mt2 * 128 + srow) * g.lda + skc * 8;
      Bp0 = g.Bt + (long)(nt2 * 128 + srow) * g.K + skc * 8;
      G_LOAD(0, 0)
      G_LOAD(1, 1)
    }
    gemm_epi(acc, m0, n0, g.Nv, epi, smem);
  }
#endif
}

DI void merge_phase(int l, char* smem) {
  PP p = get_params();
  const int G = gridDim.x;
  const bool xo = (G & 7) == 0;
  const int band = xo ? 16 : 128, ustep = xo ? G >> 3 : G, u0 = xo ? (int)(blockIdx.x >> 3) : (int)blockIdx.x, mbase = xo ? (int)(blockIdx.x & 7) * 16 : 0;
  for (int u = u0; u < band * 8; u += ustep) {
    const int nt = u / band, mt = mbase + (u - nt * band), m0 = mt * 128, n0 = nt * 128;
    const int lane = otid() & 63, wave = otid() >> 6;
    const int r = lane & 31, hh = lane >> 5, wm = wave >> 1, wn = wave & 1;
    f32x16 tot[2][2];
#pragma unroll
    for (int a = 0; a < 2; ++a)
#pragma unroll
      for (int b = 0; b < 2; ++b)
#pragma unroll
        for (int i = 0; i < 16; ++i) tot[a][b][i] = 0.f;
#pragma unroll 1
    for (int br = 0; br < 3; ++br) {
      GemmSpec g;
      if (br == 0) { g.A = p->Y + C_RGG; g.lda = NIN; g.Bt = p->wb + W_BA; g.W = (const float*)p->in[18] + (long)l * 1048576; }
      else if (br == 1) { g.A = p->Y + C_SBQ; g.lda = NIN; g.Bt = p->wb + W_BB; g.W = (const float*)p->in[19] + (long)l * 1048576; }
      else { g.A = p->hb; g.lda = 1024; g.Bt = p->wb + W_BC; g.W = (const float*)p->in[20] + (long)l * 1048576; }
      g.K = 1024; g.Nv = 1024; g.ldw = 1024; g.mapmode = 0; g.kscale = nullptr;
      f32x16 acc[2][2];
      gemm_main<2, 2, 2>(g, m0, n0, acc, smem);
      const bf16_t* gbase = p->Y + C_GATE + br * 1024;
#pragma unroll
      for (int mi = 0; mi < 2; ++mi)
#pragma unroll
        for (int ni = 0; ni < 2; ++ni)
#pragma unroll
          for (int gq = 0; gq < 4; ++gq) {
            int m = m0 + wm * 64 + mi * 32 + r, n = n0 + wn * 64 + ni * 32 + 8 * gq + 4 * hh;
            uint2 gl = *(const uint2*)(gbase + (long)m * NIN + n);
            tot[mi][ni][4 * gq + 0] += sigmoidf_(bflo(gl.x)) * acc[mi][ni][4 * gq + 0];
            tot[mi][ni][4 * gq + 1] += sigmoidf_(bfhi(gl.x)) * acc[mi][ni][4 * gq + 1];
            tot[mi][ni][4 * gq + 2] += sigmoidf_(bflo(gl.y)) * acc[mi][ni][4 * gq + 2];
            tot[mi][ni][4 * gq + 3] += sigmoidf_(bfhi(gl.y)) * acc[mi][ni][4 * gq + 3];
          }
    }
    struct EpiPlain {
      bf16_t* out;
      DI EpiDest dest(int mw, int nw) const { return EpiDest{0, out + (long)mw * 1024 + nw, 1024}; }
      DI void compute(int, int, const float (&v0)[4], const float (&v1)[4], float (&o0)[4], float (&o1)[4]) const {
#pragma unroll
        for (int j = 0; j < 4; ++j) { o0[j] = v0[j]; o1[j] = v1[j]; }
      }
    } ep{p->qb};
    gemm_epi(tot, m0, n0, 1024, ep, smem);
  }
}

DI void rg_item(int l, int item, int stage, char* smem, int dmy) {
  PP p = get_params();
  const int b = item >> 10, c = (item >> 4) & 63, nb = item & 15, cb = nb * 64, t0 = c * 64;
  const int tid = otid(), lane = tid & 63, wave = tid >> 6, r = lane & 31, hh = lane >> 5;
  float* xs = (float*)smem;
  float* aa = xs;
  float* uf = xs + 67 * 64;
  bf16_t* ub = (bf16_t*)(uf + 64 * 64);
  bf16_t* wa = ub + 64 * 72;
  bf16_t* wx = wa + 64 * 72;
  float* cst = (float*)(wx + 64 * 72);
  bf16_t* Yb = p->Y + (long)b * SEQ * NIN;
  float* sumA = p->rgsum + ((long)b * 64) * 2048 + cb;
  __syncthreads();
  float hstate = 0.f;
  if (stage == 1 && wave == 0) {
#pragma unroll 8
    for (int cc = 0; cc < c; ++cc) hstate = sumA[(long)cc * 2048 + lane] * hstate + sumA[(long)cc * 2048 + 1024 + lane];
  }
  if (tid < 64) {
    int ch = cb + tid;
    cst[0 * 64 + tid] = ((const float*)p->in[10])[l * 1024 + ch];
    cst[1 * 64 + tid] = ((const float*)p->in[12])[l * 1024 + ch];
    float lam = ((const float*)p->in[13])[l * 1024 + ch];
    cst[2 * 64 + tid] = log1pf(expf(-lam));
    cst[3 * 64 + tid] = ((const float*)p->in[8])[l * 1024 + ch];
#pragma unroll
    for (int tap = 0; tap < 4; ++tap) cst[(4 + tap) * 64 + tid] = ((const float*)p->in[7])[(l * 4 + tap) * 1024 + ch];
  }
#pragma unroll
  for (int i = 0; i < 2; ++i) {
    int e = tid + 256 * i, row = e >> 3, kc = e & 7;
    *(uint4*)(wa + row * 72 + kc * 8) = *(const uint4*)(p->wb + W_RGA + nb * 4096 + row * 64 + kc * 8);
    *(uint4*)(wx + row * 72 + kc * 8) = *(const uint4*)(p->wb + W_RGX + nb * 4096 + row * 64 + kc * 8);
  }
#pragma unroll
  for (int i = 0; i < 3; ++i) {
    int e = tid + 256 * i;
    if (e < 67 * 8) {
      int rr = e >> 3, kc = e & 7, t = t0 - 3 + rr;
      uint4 v = make_uint4(0u, 0u, 0u, 0u);
      if (t >= 0) v = *(const uint4*)(Yb + (long)t * NIN + C_RGX + cb + kc * 8);
      float* d = xs + rr * 64 + kc * 8;
      d[0] = bflo(v.x); d[1] = bfhi(v.x); d[2] = bflo(v.y); d[3] = bfhi(v.y); d[4] = bflo(v.z); d[5] = bfhi(v.z); d[6] = bflo(v.w); d[7] = bfhi(v.w);
    }
  }
  __syncthreads();
  {
    const int ch = tid & 63, tq = tid >> 6;
    const float cbias = cst[3 * 64 + ch], w0 = cst[4 * 64 + ch], w1 = cst[5 * 64 + ch], w2 = cst[6 * 64 + ch], w3 = cst[7 * 64 + ch];
#pragma unroll 4
    for (int tt = 0; tt < 16; ++tt) {
      int t = tq * 16 + tt;
      float u = cbias + w0 * xs[(t + 0) * 64 + ch] + w1 * xs[(t + 1) * 64 + ch] + w2 * xs[(t + 2) * 64 + ch] + w3 * xs[(t + 3) * 64 + ch];
      uf[t * 64 + ch] = u;
      ub[t * 72 + ch] = f2bf(u);
    }
  }
  __syncthreads();
  {
    const int tb = 32 * (wave >> 1), cb2 = 32 * (wave & 1);
    f32x16 accA, accX;
#pragma unroll
    for (int i = 0; i < 16; ++i) { accA[i] = 0.f; accX[i] = 0.f; }
#if !NAIVE_RG
#pragma unroll
    for (int kk = 0; kk < 4; ++kk) {
      bf16x8 uu = *(const bf16x8*)(ub + (tb + r) * 72 + kk * 16 + hh * 8);
      bf16x8 fa = *(const bf16x8*)(wa + (cb2 + r) * 72 + kk * 16 + hh * 8);
      bf16x8 fx = *(const bf16x8*)(wx + (cb2 + r) * 72 + kk * 16 + hh * 8);
      accA = MFMA(fa, uu, accA);
      accX = MFMA(fx, uu, accX);
    }
#else
    {
      const float* Wa = (const float*)p->in[9] + (long)l * 65536 + nb * 4096;
      const float* Wx = (const float*)p->in[11] + (long)l * 65536 + nb * 4096;
      for (int j = 0; j < 64; ++j) {
        float u = uf[(tb + r) * 64 + j];
#pragma unroll
        for (int i = 0; i < 16; ++i) { int ko = cb2 + crow(i, hh); accA[i] += u * Wa[j * 64 + ko]; accX[i] += u * Wx[j * 64 + ko]; }
      }
    }
#endif
#pragma unroll
    for (int i = 0; i < 16; ++i) {
      int ch = cb2 + crow(i, hh), t = tb + r;
      float rg = sigmoidf_(accA[i] + cst[0 * 64 + ch]);
      float ig = sigmoidf_(accX[i] + cst[1 * 64 + ch]);
      float la = -8.f * cst[2 * 64 + ch] * rg;
      float a = __expf(la);
      float bc = sqrtf(fmaxf(1.f - a * a, 0.f)) * ig * uf[t * 64 + ch];
      aa[t * 64 + ch] = a;
      uf[t * 64 + ch] = bc;
    }
  }
  __syncthreads();
  if (stage == 0) {
    if (wave == 0) {
      float ap = 1.f, h = 0.f;
#pragma unroll 8
      for (int t = 0; t < 64; ++t) { float a = aa[t * 64 + lane]; h = a * h + uf[t * 64 + lane]; ap *= a; }
      sumA[(long)c * 2048 + lane] = ap;
      sumA[(long)c * 2048 + 1024 + lane] = h;
    }
    return;
  }
  if (wave == 0) {
#pragma unroll 8
    for (int t = 0; t < 64; ++t) { hstate = aa[t * 64 + lane] * hstate + uf[t * 64 + lane]; uf[t * 64 + lane] = hstate; }
  }
  __syncthreads();
#pragma unroll
  for (int i = 0; i < 2; ++i) {
    int e = tid + 256 * i, t = e >> 3, kc = e & 7;
    bf16_t* gp = Yb + (long)(t0 + t) * NIN + C_RGG + cb + kc * 8;
    uint4 g = *(const uint4*)gp;
    const float* hp = uf + t * 64 + kc * 8;
    uint4 o;
    o.x = pack2(hp[0] * gelu_tanh(bflo(g.x)), hp[1] * gelu_tanh(bfhi(g.x)));
    o.y = pack2(hp[2] * gelu_tanh(bflo(g.y)), hp[3] * gelu_tanh(bfhi(g.y)));
    o.z = pack2(hp[4] * gelu_tanh(bflo(g.z)), hp[5] * gelu_tanh(bfhi(g.z)));
    o.w = pack2(hp[6] * gelu_tanh(bflo(g.w)), hp[7] * gelu_tanh(bfhi(g.w)));
    bf16_t* op = dmy ? p->vtb + ((long)b * SEQ + t0 + t) * 1024 + cb + kc * 8 : gp;
    *(uint4*)op = o;
  }
}

constexpr float SB_SCALE = 0.08838834764831845f;
constexpr float MLA_SCALE = 0.07216878364870323f;

DI void sb_item(int item, char* smem, int dmy) {
  PP p = get_params();
  const int qblk = 31 - (item >> 5), bh = item & 31, b = bh >> 3, hd = bh & 7;
  const int tid = otid(), lane = tid & 63, wave = tid >> 6, r = lane & 31, hh = lane >> 5;
  bf16_t* Yb = p->Y + (long)b * SEQ * NIN;
  const int qs = qblk * 128 + wave * 32;
#if !NAIVE_ATTN
  bf16_t* sK = (bf16_t*)smem;
  bf16_t* sV = sK + 64 * 136;
  bf16x8 qf[8];
#pragma unroll
  for (int kk = 0; kk < 8; ++kk) qf[kk] = *(const bf16x8*)(Yb + (long)(qs + r) * NIN + C_SBQ + hd * 128 + kk * 16 + hh * 8);
  f32x16 o[4];
#pragma unroll
  for (int dt = 0; dt < 4; ++dt)
#pragma unroll
    for (int i = 0; i < 16; ++i) o[dt][i] = 0.f;
  float cy = 0.f;
  const bf16_t* Kg = Yb + C_SBK + hd * 128;
  const bf16_t* Vg = p->vtb + (long)(b * 8 + hd) * 128 * SEQ;
  const int ntiles = qblk * 2 + 2;
  const int krow_ = tid >> 4, kkc = tid & 15, vrow = tid >> 3, vkc = tid & 7;
  uint4 rk0, rk1, rk2, rk3, rv0, rv1, rv2, rv3;
  const bf16_t* kgp = Kg + (long)krow_ * NIN + kkc * 8;
  const bf16_t* vgp = Vg + (long)vrow * SEQ + vkc * 8;
#define SB_LOAD(KT) { const bf16_t* kq = kgp + (long)((KT) * 64) * NIN; const bf16_t* vq = vgp + (KT) * 64; \
    rk0 = *(const uint4*)(kq); rk1 = *(const uint4*)(kq + 16L * NIN); rk2 = *(const uint4*)(kq + 32L * NIN); rk3 = *(const uint4*)(kq + 48L * NIN); \
    rv0 = *(const uint4*)(vq); rv1 = *(const uint4*)(vq + 32L * SEQ); rv2 = *(const uint4*)(vq + 64L * SEQ); rv3 = *(const uint4*)(vq + 96L * SEQ); }
#define ST_V(ROW, RV) { bf16_t* dq = sV + (ROW) * 72 + (vkc >> 1) * 16 + (vkc & 1) * 4; *(uint2*)dq = make_uint2(RV.x, RV.y); *(uint2*)(dq + 8) = make_uint2(RV.z, RV.w); }
  SB_LOAD(ntiles - 1)
  int wdone = 0;
  volatile int* dflag = (volatile int*)(smem + SMEM_ITEM + 16);
  __syncthreads();
  if (lane == 0) dflag[wave] = 0;
  for (int kt = ntiles - 1; kt >= 0; --kt) {
    __syncthreads();
    if ((dflag[0] & dflag[1] & dflag[2] & dflag[3]) != 0) break;
    *(uint4*)(sK + (krow_) * 136 + kkc * 8) = rk0; *(uint4*)(sK + (krow_ + 16) * 136 + kkc * 8) = rk1;
    *(uint4*)(sK + (krow_ + 32) * 136 + kkc * 8) = rk2; *(uint4*)(sK + (krow_ + 48) * 136 + kkc * 8) = rk3;
    ST_V(vrow, rv0) ST_V(vrow + 32, rv1) ST_V(vrow + 64, rv2) ST_V(vrow + 96, rv3)
    __syncthreads();
    if (kt > 0) SB_LOAD(kt - 1)
#pragma unroll 1
    for (int sub = 1; sub >= 0; --sub) {
      const int ks = kt * 64 + sub * 32;
      if (wdone || ks >= qs + 31) continue;
      f32x16 S;
#pragma unroll
      for (int i = 0; i < 16; ++i) S[i] = 0.f;
#pragma unroll
      for (int kk = 0; kk < 8; ++kk) {
        bf16x8 kf = *(const bf16x8*)(sK + (sub * 32 + r) * 136 + kk * 16 + hh * 8);
        S = MFMA(kf, qf[kk], S);
      }
      const bool diag = (ks + 31 >= qs);
      const int tq = qs + r;
      float lk[16], ls[16];
#pragma unroll
      for (int i = 0; i < 16; ++i) {
        float z = S[i] * SB_SCALE;
        float e = __expf(-fabsf(z));
        float l1p = __logf(1.f + e);
        ls[i] = fminf(z, 0.f) - l1p;
        lk[i] = ls[i] - z;
        if (diag) { bool valid = (ks + crow(i, hh)) < tq; if (!valid) { lk[i] = 0.f; ls[i] = -1e30f; } }
      }
      float own[4], oth[4];
#pragma unroll
      for (int gq = 0; gq < 4; ++gq) own[gq] = (lk[4 * gq] + lk[4 * gq + 1]) + (lk[4 * gq + 2] + lk[4 * gq + 3]);
#pragma unroll
      for (int gq = 0; gq < 4; ++gq) oth[gq] = __shfl_xor(own[gq], 32);
      float sg = cy;
      float w[16];
#pragma unroll
      for (int gq = 3; gq >= 0; --gq) {
        float run = sg + (hh == 0 ? oth[gq] : 0.f);
#pragma unroll
        for (int j = 3; j >= 0; --j) { w[4 * gq + j] = __expf(ls[4 * gq + j] + run); run += lk[4 * gq + j]; }
        sg += own[gq] + oth[gq];
      }
      cy = sg;
      wdone = (__builtin_amdgcn_ballot_w64(cy >= -110.f) == 0ull);
      if (wdone && lane == 0) dflag[wave] = 1;
#pragma unroll
      for (int s = 0; s < 2; ++s) {
        uint4 pk;
        pk.x = pack2(w[8 * s + 0], w[8 * s + 1]); pk.y = pack2(w[8 * s + 2], w[8 * s + 3]);
        pk.z = pack2(w[8 * s + 4], w[8 * s + 5]); pk.w = pack2(w[8 * s + 6], w[8 * s + 7]);
        bf16x8 pf = __builtin_bit_cast(bf16x8, pk);
#pragma unroll
        for (int dt = 0; dt < 4; ++dt) {
          const uint4 vv = *(const uint4*)(sV + (dt * 32 + r) * 72 + sub * 32 + 16 * s + 8 * hh);
          o[dt] = MFMA(__builtin_bit_cast(bf16x8, vv), pf, o[dt]);
        }
      }
    }
  }
#pragma unroll
  for (int dt = 0; dt < 4; ++dt)
#pragma unroll
    for (int gq = 0; gq < 4; ++gq) {
      float ov[4] = {o[dt][4 * gq], o[dt][4 * gq + 1], o[dt][4 * gq + 2], o[dt][4 * gq + 3]};
      bf16_t* ob = dmy ? p->hb + (long)b * SEQ * 1024 + hd * 128 : Yb + C_SBQ + hd * 128;
      const long os = dmy ? 1024 : NIN;
      store4bf(ob + (long)(qs + r) * os + dt * 32 + 8 * gq + 4 * hh, ov);
    }
#else
  const bf16_t* Vg = p->vtb + (long)(b * 8 + hd) * 128 * SEQ;
  for (int ri = 0; ri < 32; ++ri) {
    const int t = qs + ri;
    unsigned qq = *(const unsigned*)(Yb + (long)t * NIN + C_SBQ + hd * 128 + 2 * lane);
    const float q0 = bflo(qq), q1 = bfhi(qq);
    float o0 = 0.f, o1 = 0.f, cyv = 0.f;
    for (int s = t - 1; s >= 0; --s) {
      unsigned kk2 = *(const unsigned*)(Yb + (long)s * NIN + C_SBK + hd * 128 + 2 * lane);
      float part = q0 * bflo(kk2) + q1 * bfhi(kk2);
#pragma unroll
      for (int of = 32; of >= 1; of >>= 1) part += __shfl_xor(part, of);
      float z = part * SB_SCALE;
      float lsg = fminf(z, 0.f) - log1pf(expf(-fabsf(z)));
      float wgt = expf(lsg + cyv);
      cyv += lsg - z;
      float v0 = bf2f(Vg[(long)(2 * lane) * SEQ + s]), v1 = bf2f(Vg[(long)(2 * lane + 1) * SEQ + s]);
      o0 += wgt * v0; o1 += wgt * v1;
    }
    *(unsigned*)(Yb + (long)t * NIN + C_SBQ + hd * 128 + 2 * lane) = pack2(o0, o1);
  }
#endif
}

DI void mla_item(int item, char* smem) {
  PP p = get_params();
  const int qblk = 31 - (item >> 5), bh = item & 31, b = bh >> 3, hd = bh & 7;
  const int tid = otid(), lane = tid & 63, wave = tid >> 6, r = lane & 31, hh = lane >> 5;
  const int qs = qblk * 128 + wave * 32;
  const bf16_t* Qg = p->qb + (long)b * SEQ * 1536 + hd * 192;
  const bf16_t* Kn = p->kb + (long)b * SEQ * 1024 + hd * 128;
  const bf16_t* Kr = p->Y + (long)b * SEQ * NIN + C_KR;
  const bf16_t* Vg = p->vtc + (long)(b * 8 + hd) * 128 * SEQ;
  bf16_t* Og = p->hb + (long)b * SEQ * 1024 + hd * 128;
#if !NAIVE_ATTN
  bf16_t* sK = (bf16_t*)smem;
  bf16_t* sR = sK + 64 * 136;
  bf16_t* sV = sR + 64 * 72;
  bf16x8 qf[12];
#pragma unroll
  for (int kk = 0; kk < 12; ++kk) qf[kk] = *(const bf16x8*)(Qg + (long)(qs + r) * 1536 + kk * 16 + hh * 8);
  f32x16 o[4];
#pragma unroll
  for (int dt = 0; dt < 4; ++dt)
#pragma unroll
    for (int i = 0; i < 16; ++i) o[dt][i] = 0.f;
  float mrun = -1e30f, lrun = 0.f;
  const int nt_blk = qblk * 2 + 2, nt_w = (qs >> 6) + 1;
  const int krow_ = tid >> 4, kkc = tid & 15, vrow = tid >> 3, vkc = tid & 7;
  uint4 rk0, rk1, rk2, rk3, rv0, rv1, rv2, rv3, rr0, rr1;
  const bf16_t* kgp = Kn + (long)krow_ * 1024 + kkc * 8;
  const bf16_t* vgp = Vg + (long)vrow * SEQ + vkc * 8;
  const bf16_t* rgp = Kr + (long)vrow * NIN + vkc * 8;
#define MLA_LOAD(KT) { const bf16_t* kq = kgp + (long)((KT) * 64) * 1024; const bf16_t* vq = vgp + (KT) * 64; const bf16_t* rq = rgp + (long)((KT) * 64) * NIN; \
    rk0 = *(const uint4*)(kq); rk1 = *(const uint4*)(kq + 16L * 1024); rk2 = *(const uint4*)(kq + 32L * 1024); rk3 = *(const uint4*)(kq + 48L * 1024); \
    rv0 = *(const uint4*)(vq); rv1 = *(const uint4*)(vq + 32L * SEQ); rv2 = *(const uint4*)(vq + 64L * SEQ); rv3 = *(const uint4*)(vq + 96L * SEQ); \
    rr0 = *(const uint4*)(rq); rr1 = *(const uint4*)(rq + 32L * NIN); }
  MLA_LOAD(0)
  for (int kt = 0; kt < nt_blk; ++kt) {
    __syncthreads();
    *(uint4*)(sK + (krow_) * 136 + kkc * 8) = rk0; *(uint4*)(sK + (krow_ + 16) * 136 + kkc * 8) = rk1;
    *(uint4*)(sK + (krow_ + 32) * 136 + kkc * 8) = rk2; *(uint4*)(sK + (krow_ + 48) * 136 + kkc * 8) = rk3;
    ST_V(vrow, rv0) ST_V(vrow + 32, rv1) ST_V(vrow + 64, rv2) ST_V(vrow + 96, rv3)
    *(uint4*)(sR + (vrow) * 72 + vkc * 8) = rr0; *(uint4*)(sR + (vrow + 32) * 72 + vkc * 8) = rr1;
    __syncthreads();
    if (kt + 1 < nt_blk) MLA_LOAD(kt + 1)
    if (kt < nt_w) {
#define MLA_QK(SUB, SV) { \
        _Pragma("unroll") for (int i = 0; i < 16; ++i) SV[i] = 0.f; \
        _Pragma("unroll") for (int kk = 0; kk < 8; ++kk) { \
          bf16x8 kf = *(const bf16x8*)(sK + ((SUB) * 32 + r) * 136 + kk * 16 + hh * 8); \
          SV = MFMA(kf, qf[kk], SV); } \
        _Pragma("unroll") for (int kk = 0; kk < 4; ++kk) { \
          bf16x8 kf = *(const bf16x8*)(sR + ((SUB) * 32 + r) * 72 + kk * 16 + hh * 8); \
          SV = MFMA(kf, qf[8 + kk], SV); } }
#define MLA_SM_PV(SUB, SV) { \
        uint4 vfr[2][4]; \
        _Pragma("unroll") for (int s2 = 0; s2 < 2; ++s2) \
          _Pragma("unroll") for (int dt = 0; dt < 4; ++dt) { \
            vfr[s2][dt] = *(const uint4*)(sV + (dt * 32 + r) * 72 + (SUB) * 32 + 16 * s2 + 8 * hh); } \
        float mx = SV[0]; \
        _Pragma("unroll") for (int i = 1; i < 16; ++i) mx = fmaxf(mx, SV[i]); \
        mx = fmaxf(mx, __shfl_xor(mx, 32)); \
        const float mnew = fmaxf(mrun, mx * MLA_SCALE); \
        if (__builtin_amdgcn_ballot_w64(mnew > mrun + 8.f) != 0ull) {     \
          const float alpha = __expf(mrun - mnew); \
          lrun *= alpha; \
          _Pragma("unroll") for (int dt = 0; dt < 4; ++dt) \
            _Pragma("unroll") for (int i = 0; i < 16; ++i) o[dt][i] *= alpha; \
          mrun = mnew; \
        } \
        float psum = 0.f; \
        _Pragma("unroll") for (int i = 0; i < 16; ++i) { float pv = __expf(SV[i] * MLA_SCALE - mrun); SV[i] = pv; psum += pv; } \
        lrun += psum; \
        _Pragma("unroll") for (int s2 = 0; s2 < 2; ++s2) { \
          uint4 pk; \
          pk.x = pack2(SV[8 * s2 + 0], SV[8 * s2 + 1]); pk.y = pack2(SV[8 * s2 + 2], SV[8 * s2 + 3]); \
          pk.z = pack2(SV[8 * s2 + 4], SV[8 * s2 + 5]); pk.w = pack2(SV[8 * s2 + 6], SV[8 * s2 + 7]); \
          bf16x8 pf = __builtin_bit_cast(bf16x8, pk); \
          _Pragma("unroll") for (int dt = 0; dt < 4; ++dt) o[dt] = MFMA(__builtin_bit_cast(bf16x8, vfr[s2][dt]), pf, o[dt]); \
          } }
      f32x16 S0, S1;
      MLA_QK(0, S0)
      MLA_QK(1, S1)
      __builtin_amdgcn_sched_barrier(0);
      MLA_SM_PV(0, S0)
      __builtin_amdgcn_sched_barrier(0);
      MLA_SM_PV(1, S1)
#undef MLA_QK
#undef MLA_SM_PV
    }
  }
  const float ltot = lrun + __shfl_xor(lrun, 32);
  const float linv = 1.f / ltot;
#pragma unroll
  for (int dt = 0; dt < 4; ++dt)
#pragma unroll
    for (int gq = 0; gq < 4; ++gq) {
      float ov[4] = {o[dt][4 * gq] * linv, o[dt][4 * gq + 1] * linv, o[dt][4 * gq + 2] * linv, o[dt][4 * gq + 3] * linv};
      store4bf(Og + (long)(qs + r) * 1024 + dt * 32 + 8 * gq + 4 * hh, ov);
    }
#else
  for (int ri = 0; ri < 32; ++ri) {
    const int t = qs + ri;
    unsigned qq = *(const unsigned*)(Qg + (long)t * 1536 + 2 * lane);
    const float q0 = bflo(qq), q1 = bfhi(qq), q2 = bf2f(Qg[(long)t * 1536 + 128 + lane]);
    float o0 = 0.f, o1 = 0.f, mr = -1e30f, lr = 0.f;
    const int kend = ((t >> 6) + 1) * 64;
    for (int s = 0; s < kend; ++s) {
      unsigned kk2 = *(const unsigned*)(Kn + (long)s * 1024 + 2 * lane);
      float part = q0 * bflo(kk2) + q1 * bfhi(kk2) + q2 * bf2f(Kr[(long)s * NIN + lane]);
#pragma unroll
      for (int of = 32; of >= 1; of >>= 1) part += __shfl_xor(part, of);
      float sc = part * MLA_SCALE;
      float mn = fmaxf(mr, sc), al = expf(mr - mn), pv = expf(sc - mn);
      mr = mn; lr = lr * al + pv;
      float v0 = bf2f(Vg[(long)(2 * lane) * SEQ + s]), v1 = bf2f(Vg[(long)(2 * lane + 1) * SEQ + s]);
      o0 = o0 * al + pv * v0; o1 = o1 * al + pv * v1;
    }
    *(unsigned*)(Og + (long)t * 1024 + 2 * lane) = pack2(o0 / lr, o1 / lr);
  }
#endif
}

DI void mla_rinv(const bf16_t* A, int m0, float* rinv) {
  const int tid = otid(), row = tid >> 1, half = tid & 1;
  const bf16_t* ap = A + (long)(m0 + row) * NIN + half * 128;
  float ss = 0.f;
#pragma unroll 4
  for (int i = 0; i < 16; ++i) {
    uint4 v = *(const uint4*)(ap + i * 8);
    float a0 = bflo(v.x), a1 = bfhi(v.x), a2 = bflo(v.y), a3 = bfhi(v.y), a4 = bflo(v.z), a5 = bfhi(v.z), a6 = bflo(v.w), a7 = bfhi(v.w);
    ss += a0 * a0 + a1 * a1 + a2 * a2 + a3 * a3 + a4 * a4 + a5 * a5 + a6 * a6 + a7 * a7;
  }
  ss += __shfl_xor(ss, 1);
  __syncthreads();
  if (half == 0) rinv[row] = rsqrtf(ss * (1.f / 256.f) + 1e-6f);
  __syncthreads();
}

DI void mla_up_item(int l, int idx, bool isq, char* smem) {
  PP p = get_params();
  float* rinv = (float*)(smem + SMEM_RINV);
  GemmSpec g;
  int mt, nt;
  if (isq) { mt = idx / 12; nt = idx - mt * 12; g.A = p->Y + C_CQ; g.Bt = p->wb + W_UQ; g.Nv = 1536; g.W = (const float*)p->in[15] + (long)l * 256 * 1536; g.ldw = 1536; g.kscale = (const float*)p->in[14] + l * 256; }
  else { mt = idx >> 4; nt = idx & 15; g.A = p->Y + C_CKV; g.Bt = p->wb + W_UKV; g.Nv = 2048; g.W = (const float*)p->in[17] + (long)l * 256 * 2048; g.ldw = 2048; g.kscale = (const float*)p->in[16] + l * 256; }
  g.lda = NIN; g.K = 256; g.mapmode = 0;
  const int m0 = mt * 128, n0 = nt * 128;
  mla_rinv(g.A, m0, rinv);
  f32x16 acc[2][2];
  gemm_main<2, 2>(g, m0, n0, acc, smem);
  if (isq) { EpiQ e{p->qb, rinv, m0, p->cosb, p->sinb}; gemm_epi(acc, m0, n0, g.Nv, e, smem); }
  else { EpiKV e{p->kb, p->vtc, rinv, m0}; gemm_epi(acc, m0, n0, g.Nv, e, smem); }
}

DI int next_item(int* ctr, char* smem) {
  int* sh = (int*)(smem + SMEM_ITEM);
  __syncthreads();
  if (otid() == 0) *sh = atomicAdd(ctr, 1);
  __syncthreads();
  return *sh;
}

DI void grid_barrier(unsigned* bar, unsigned k) {
  asm volatile("s_waitcnt vmcnt(0)" ::: "memory");
  __syncthreads();
  if (otid() == 0) {
    __builtin_amdgcn_fence(__ATOMIC_RELEASE, "agent");
    asm volatile("s_waitcnt vmcnt(0)" ::: "memory");
    const unsigned G = gridDim.x, grp = blockIdx.x & 7u;
    const unsigned gsz = (G + 7u - grp) >> 3;
    const unsigned ngrp = G < 8u ? G : 8u;
    unsigned old = __hip_atomic_fetch_add(bar + 32 * (1 + grp), 1u, __ATOMIC_RELAXED, __HIP_MEMORY_SCOPE_AGENT);
    if (old + 1u == (k + 1u) * gsz) __hip_atomic_fetch_add(bar, 1u, __ATOMIC_RELAXED, __HIP_MEMORY_SCOPE_AGENT);
    while (__hip_atomic_load(bar, __ATOMIC_RELAXED, __HIP_MEMORY_SCOPE_AGENT) < (k + 1u) * ngrp) __builtin_amdgcn_s_sleep(4);
    __builtin_amdgcn_fence(__ATOMIC_ACQUIRE, "agent");
    asm volatile("s_waitcnt vmcnt(0)" ::: "memory");
  }
  __syncthreads();
}

DI void init_phase() {
  PP p = get_params();
  {
    if (!EN(15)) return;
    const float4* xin = (const float4*)p->in[0];
    float4* xo = (float4*)p->xres;
    const long n4 = (long)T_TOK * DM / 4;
    for (long i = (long)blockIdx.x * 256 + otid(); i < n4; i += (long)gridDim.x * 256) xo[i] = xin[i];
    const int* pos = (const int*)p->in[1];
    for (int i = blockIdx.x * 256 + otid(); i < T_TOK * 32; i += gridDim.x * 256) {
      int tok = i >> 5, f = i & 31;
      float inv = (float)exp(-(double)(2 * f) / 64.0 * 9.210340371976184);
      float ang = (float)pos[tok] * inv;
      p->cosb[i] = cosf(ang); p->sinb[i] = sinf(ang);
    }
    return;
  }
}

DI void run_phase(int ph, char* smem) {
  PP p = get_params();
  if (ph == NPH - 1) { if (EN(15)) norm_phase<true>(p->xres, (const float*)p->in[25], nullptr, p->xres); return; }
  const int l = (ph - 1) / 12, j = (ph - 1) % 12;
  switch (j) {
    case 0: for (int rep = 0; rep < REP_NORM; ++rep) { if (EN(0)) convert_layer(l, smem); if (EN(15)) norm_phase<false>(l == 0 ? (const float*)p->in[0] : (const float*)p->xres, (const float*)p->in[2] + l * DM, p->hb, nullptr); } break;
    case 1: case 10: if (EN(1)) {
      GemmSpec g; g.A = p->hb; g.lda = 1024; g.Bt = p->wb + (j == 1 ? W_GU1 : W_GU2); g.K = 1024; g.Nv = 5632;
      g.W = (const float*)p->in[j == 1 ? 3 : 23] + (long)l * 1024 * 5632; g.ldw = 5632; g.mapmode = 1; g.kscale = nullptr;
      EpiSwiglu e{p->Y};
      for (int rep = 0; rep < REP_FFN; ++rep) gemm_phase(g, e, smem);
    } break;
    case 2: case 11: if (EN(2)) {
      GemmSpec g; g.A = p->Y; g.lda = DFF; g.Bt = p->wb + (j == 2 ? W_D1 : W_D2); g.K = DFF; g.Nv = 1024;
      g.W = (const float*)p->in[j == 2 ? 4 : 24] + (long)l * 2816 * 1024; g.ldw = 1024; g.mapmode = 0; g.kscale = nullptr;
      for (int rep = 0; rep < REP_FFN; ++rep) { EpiResid e{p->xres, rep == REP_FFN - 1 ? 0.5f : 0.f}; gemm_phase(g, e, smem); }
    } break;
    case 3: for (int rep = 0; rep < REP_NORM; ++rep) if (EN(15)) norm_phase<false>(p->xres, (const float*)p->in[5] + l * DM, p->hb, nullptr); break;
    case 4: if (EN(4)) {
      GemmSpec g; g.A = p->hb; g.lda = 1024; g.Bt = p->wb + W_IN; g.K = 1024; g.Nv = NIN;
      g.W = (const float*)p->in[6] + (long)l * 1024 * NIN; g.ldw = NIN; g.mapmode = 0; g.kscale = nullptr;
      EpiWin e{p->Y, p->vtb, p->cosb, p->sinb};
      for (int rep = 0; rep < REP_WIN; ++rep) gemm_phase(g, e, smem);
    } break;
    case 5: {
      const int G = gridDim.x, b0 = blockIdx.x;
      for (int it = b0; it < 1024; it += G) { if (EN(13)) for (int rep = 0; rep < REP_SB; ++rep) sb_item(it, smem, rep < REP_SB - 1); }
      for (int it = b0; it < 1536; it += G) { if (EN(14)) for (int rep = 0; rep < REP_UP; ++rep) mla_up_item(l, it, true, smem); }
      for (int it = b0; it < 2048; it += G) { if (EN(14)) for (int rep = 0; rep < REP_UP; ++rep) mla_up_item(l, it, false, smem); }
      for (int it = b0; it < 4096; it += G) { if (EN(12)) for (int rep = 0; rep < REP_RG; ++rep) rg_item(l, it, 0, smem, 0); }
    } break;
    case 6: {
      const int G = gridDim.x, b0 = blockIdx.x;
      for (int it = b0; it < 512; it += G) {
        if (EN(6)) for (int rep = 0; rep < REP_MLA; ++rep) { mla_item(it, smem); mla_item(1023 - it, smem); }
      }
      for (int it = b0; it < 4096; it += G) { if (EN(12)) for (int rep = 0; rep < REP_RG; ++rep) rg_item(l, it, 1, smem, rep < REP_RG - 1); }
    } break;
    case 7: if (EN(7)) for (int rep = 0; rep < REP_MO; ++rep) merge_phase(l, smem); break;
    case 8: if (EN(8)) {
      GemmSpec g; g.A = p->qb; g.lda = 1024; g.Bt = p->wb + W_OUT; g.K = 1024; g.Nv = 1024;
      g.W = (const float*)p->in[21] + (long)l * 1048576; g.ldw = 1024; g.mapmode = 0; g.kscale = nullptr;
      for (int rep = 0; rep < REP_MO; ++rep) { EpiResid e{p->xres, rep == REP_MO - 1 ? 1.0f : 0.f}; gemm_phase(g, e, smem); }
    } break;
    case 9: for (int rep = 0; rep < REP_NORM; ++rep) if (EN(15)) norm_phase<false>(p->xres, (const float*)p->in[22] + l * DM, p->hb, nullptr); break;
  }
}

__global__ void __launch_bounds__(256, 2) mega(Params p) {
  extern __shared__ __attribute__((aligned(16))) char smem[];
  if (p.ph_lo < 0) cg::this_grid().sync();
#define GRID_SYNC(k) grid_barrier((unsigned*)(get_params()->counters + 256), (unsigned)(k))
#if PROBE
  volatile unsigned long long* tprevp = (volatile unsigned long long*)(smem + SMEM_ITEM + 16);
  volatile float* accp = (volatile float*)(smem + SMEM_ITEM + 32);
  if (threadIdx.x == 0) { *tprevp = wall_clock64(); accp[0] = 0.f; accp[1] = 0.f; }
#endif
  int ph0 = p.ph_lo, bofs = 0;
  if (ph0 == 0) {
    init_phase();
    ph0 = 1; bofs = 1;
  }
  for (int ph = ph0; ph < p.ph_hi; ++ph) {
    run_phase(ph, smem);
#if PROBE
    GRID_SYNC(ph - p.ph_lo);
    if (threadIdx.x == 0) {
      unsigned long long tn = wall_clock64();
      float dt = (float)(tn - *tprevp) * 0.01f;
      *tprevp = tn;
      float acc1 = 0.f, acc2 = 0.f;
      int j = (ph == 0 || ph == NPH - 1) ? 12 : (ph - 1) % 12;
      if (PROBE == 1) { if (j == 5) acc1 += dt; if (j == 6) acc2 += dt; }
      if (PROBE == 2) { if (j == 1 || j == 2 || j == 4 || j == 7 || j == 8 || j == 10 || j == 11) acc1 += dt; if (j == 0 || j == 3 || j == 9 || j == 12) acc2 += dt; }
      if (PROBE == 3) { if (j == 1 || j == 2 || j == 10 || j == 11) acc1 += dt; if (j == 4) acc2 += dt; }
      if (PROBE == 4) { if (j == 7) acc1 += dt; if (j == 8) acc2 += dt; }
      accp[0] += acc1; accp[1] += acc2;
    }
#else
    if (ph + 1 < p.ph_hi) GRID_SYNC(ph - p.ph_lo - bofs);
#endif
  }
#if PROBE
  {
    PP pp = get_params();
    float* slot = (float*)(pp->counters + 512);
    if (blockIdx.x == 0 && threadIdx.x == 0) { slot[0] = accp[0] * (1.f / 200.f); slot[1] = accp[1]; __threadfence(); }
    GRID_SYNC(p.ph_hi - p.ph_lo);
    float A = __hip_atomic_load(slot, __ATOMIC_RELAXED, __HIP_MEMORY_SCOPE_AGENT);
    float B = __hip_atomic_load(slot + 1, __ATOMIC_RELAXED, __HIP_MEMORY_SCOPE_AGENT);
    float* o = pp->xres;
    for (long i = (long)blockIdx.x * 256 + threadIdx.x; i < (long)T_TOK * DM; i += (long)gridDim.x * 256) o[i] = (i == 0) ? B : A;
  }
#endif
}

extern "C" void kernel_launch(void* const* d_in, const int* in_sizes, int n_in, void* d_out, int out_size, void* d_ws, size_t ws_size, hipStream_t stream) {
  static int grid = 0;
  if (!grid) {
    int dev = 0, cus = 0, per_cu = 0;
    hipGetDevice(&dev);
    hipDeviceGetAttribute(&cus, hipDeviceAttributeMultiprocessorCount, dev);
    hipFuncSetAttribute((const void*)mega, hipFuncAttributeMaxDynamicSharedMemorySize, SMEM_BYTES);
    hipOccupancyMaxActiveBlocksPerMultiprocessor(&per_cu, (const void*)mega, 256, SMEM_BYTES);
    if (per_cu < 1) per_cu = 1;
    if (per_cu > 2) per_cu = 2;
    grid = cus * per_cu;
  }
  char* ws = (char*)d_ws;
  size_t off = 0;
  auto take = [&](size_t bytes) { char* q = ws + off; off += (bytes + 255) & ~(size_t)255; return q; };
  Params p{};
  for (int i = 0; i < 26; ++i) p.in[i] = d_in[i];
  p.xres = (float*)d_out;
  p.counters = (int*)take(4096);
  p.cosb = (float*)take((size_t)T_TOK * 32 * 4);
  p.sinb = (float*)take((size_t)T_TOK * 32 * 4);
  p.wb = (bf16_t*)take((size_t)W_TOTAL * 2);
  p.hb = (bf16_t*)take((size_t)T_TOK * 1024 * 2);
  p.Y = (bf16_t*)take((size_t)T_TOK * NIN * 2);
  p.qb = (bf16_t*)take((size_t)T_TOK * 1536 * 2);
  p.kb = (bf16_t*)take((size_t)T_TOK * 1024 * 2);
  p.vtc = (bf16_t*)take((size_t)T_TOK * 1024 * 2);
  p.vtb = (bf16_t*)take((size_t)T_TOK * 1024 * 2);
  p.rgsum = (float*)take((size_t)NBATCH * 64 * 2048 * 4);
  if (off > ws_size) { fprintf(stderr, "kernel_launch: workspace too small: need %zu have %zu\n", off, ws_size); return; }
  hipMemsetAsync(p.counters, 0, 4096, stream);
#if SINGLE_LAUNCH
  p.ph_lo = 0; p.ph_hi = NPH;
  void* args[] = {&p};
  hipError_t e = hipLaunchCooperativeKernel((const void*)mega, dim3(grid), dim3(256), args, SMEM_BYTES, stream);
  if (e != hipSuccess) fprintf(stderr, "cooperative launch failed: %s (grid %d)\n", hipGetErrorString(e), grid);
#else
  for (int ph = 0; ph < NPH; ++ph) {
    p.ph_lo = ph; p.ph_hi = ph + 1;
    hipLaunchKernelGGL(mega, dim3(grid), dim3(256), SMEM_BYTES, stream, p);
  }
#endif
}
```
